# Optimizing an MI355X kernel written in HIP

```python
import jax, jax.numpy as jnp
from jax import lax
import numpy as np

D_MODEL = 1024
BATCH = 16
SEQ = 2048
DEPTH = 4

CHUNK = 64
Q_BLOCK = 128
N_MEM = 256
FOX_HEADS = 8
FOX_HEAD_DIM = 64
MLA_HEADS = 8
MLA_NOPE_DIM = 64
MLA_ROPE_DIM = 32
MLA_V_DIM = 64
MLA_Q_RANK = 384
MLA_KV_RANK = 256
ROPE_BASE = 10000.0
MEM_HEADS = 4
MEM_HEAD_DIM = 128
N_BRANCHES = 3
BRANCH_WIDTH = 512
D_FF = 4 * D_MODEL
DEEPNORM_ALPHA = (2 * DEPTH) ** 0.25
DEEPNORM_BETA = (8 * DEPTH) ** -0.25
LN_EPS = 1e-5
RMS_EPS = 1e-6
NEG_INF = -1e30

IN_SPLITS = (
    3 * FOX_HEADS * FOX_HEAD_DIM,
    FOX_HEADS,
    MLA_Q_RANK,
    MLA_KV_RANK,
    MLA_ROPE_DIM,
    MEM_HEADS * MEM_HEAD_DIM,
    N_BRANCHES * D_MODEL,
)
D_IN = sum(IN_SPLITS)
SPLIT_POINTS = tuple(int(p) for p in np.cumsum(IN_SPLITS)[:-1])

kernel_name = 'hybrid_fox_mla_memory_deepnorm_trunk'


def _layer_norm(x, g, b):
    xf = x.astype(jnp.float32)
    mu = jnp.mean(xf, axis=-1, keepdims=True)
    var = jnp.mean(jnp.square(xf - mu), axis=-1, keepdims=True)
    y = (xf - mu) * lax.rsqrt(var + LN_EPS)
    return (y * g.astype(jnp.float32) + b.astype(jnp.float32)).astype(x.dtype)


def _rms_norm(x, g):
    xf = x.astype(jnp.float32)
    y = xf * lax.rsqrt(jnp.mean(jnp.square(xf), axis=-1, keepdims=True) + RMS_EPS)
    return (y * g.astype(jnp.float32)).astype(x.dtype)


def _rope_tables(positions):
    inv_freq = ROPE_BASE ** (-jnp.arange(0, MLA_ROPE_DIM, 2, dtype=jnp.float32) / MLA_ROPE_DIM)
    ang = positions.astype(jnp.float32)[..., None] * inv_freq
    return jnp.cos(ang), jnp.sin(ang)


def _rope(x, cos, sin):
    half = x.shape[-1] // 2
    x1 = x[..., :half].astype(jnp.float32)
    x2 = x[..., half:].astype(jnp.float32)
    return jnp.concatenate([x1 * cos - x2 * sin, x2 * cos + x1 * sin], axis=-1).astype(x.dtype)


def _swept_attention(q, k, v, bias_fn):
    seq = q.shape[2]
    scale = q.shape[-1] ** -0.5
    outs = []
    for i in range(seq // Q_BLOCK):
        q0 = i * Q_BLOCK
        k_len = q0 + Q_BLOCK
        logits = jnp.einsum('bhqd,bhkd->bhqk', q[:, :, q0:k_len], k[:, :, :k_len]).astype(jnp.float32)
        logits = logits * scale + bias_fn(q0, k_len)
        p = jax.nn.softmax(logits, axis=-1).astype(v.dtype)
        outs.append(jnp.einsum('bhqk,bhkd->bhqd', p, v[:, :, :k_len]))
    return jnp.concatenate(outs, axis=2)


def _chunk_causal_bias(q0, k_len):
    t_chunk = (q0 + jnp.arange(Q_BLOCK)) // CHUNK
    s_chunk = jnp.arange(k_len) // CHUNK
    allowed = s_chunk[None, :] <= t_chunk[:, None]
    return jnp.where(allowed, jnp.float32(0.0), jnp.float32(NEG_INF))[None, None]


def _mixer(h, mem, cos, sin, w_in, b_forget, w_uq, g_cq, w_ukv, g_ckv, w_mem_kv, w_br, w_out):
    B, S, _ = h.shape
    proj = h @ w_in
    fox_qkv, f_logit, c_q, c_kv, k_rope, q_mem, gate_logit = jnp.split(proj, SPLIT_POINTS, axis=-1)

    qkv = fox_qkv.reshape(B, S, 3, FOX_HEADS, FOX_HEAD_DIM).transpose(2, 0, 3, 1, 4)
    log_f = jax.nn.log_sigmoid(f_logit.astype(jnp.float32) + b_forget.astype(jnp.float32))
    cum_f = jnp.cumsum(log_f, axis=1).transpose(0, 2, 1)

    def fox_bias(q0, k_len):
        t = q0 + jnp.arange(Q_BLOCK)
        s = jnp.arange(k_len)
        decay = cum_f[:, :, q0:q0 + Q_BLOCK, None] - cum_f[:, :, None, :k_len]
        return jnp.where(s[None, :] <= t[:, None], decay, jnp.float32(NEG_INF))

    o_a = _swept_attention(qkv[0], qkv[1], qkv[2], fox_bias)
    o_a = o_a.transpose(0, 2, 1, 3).reshape(B, S, BRANCH_WIDTH)

    q_b = (_rms_norm(c_q, g_cq) @ w_uq).reshape(B, S, MLA_HEADS, MLA_NOPE_DIM + MLA_ROPE_DIM)
    q_b = q_b.transpose(0, 2, 1, 3)
    q_nope, q_pe = q_b[..., :MLA_NOPE_DIM], q_b[..., MLA_NOPE_DIM:]
    q_pe = _rope(q_pe, cos[:, None], sin[:, None])
    kv_b = (_rms_norm(c_kv, g_ckv) @ w_ukv).reshape(B, S, MLA_HEADS, MLA_NOPE_DIM + MLA_V_DIM)
    kv_b = kv_b.transpose(0, 2, 1, 3)
    k_nope, v_b = kv_b[..., :MLA_NOPE_DIM], kv_b[..., MLA_NOPE_DIM:]
    k_pe = _rope(k_rope, cos, sin)[:, None]
    q_full = jnp.concatenate([q_nope, q_pe], axis=-1)
    k_full = jnp.concatenate([k_nope, jnp.broadcast_to(k_pe, (B, MLA_HEADS, S, MLA_ROPE_DIM))], axis=-1)
    o_b = _swept_attention(q_full, k_full, v_b, _chunk_causal_bias)
    o_b = o_b.transpose(0, 2, 1, 3).reshape(B, S, BRANCH_WIDTH)

    mkv = (mem @ w_mem_kv).reshape(B, mem.shape[1], 2, MEM_HEADS, MEM_HEAD_DIM).transpose(2, 0, 3, 1, 4)
    qm = q_mem.reshape(B, S, MEM_HEADS, MEM_HEAD_DIM).transpose(0, 2, 1, 3)
    logits_m = jnp.einsum('bhqd,bhmd->bhqm', qm, mkv[0]).astype(jnp.float32) * (MEM_HEAD_DIM ** -0.5)
    p_m = jax.nn.softmax(logits_m, axis=-1).astype(mkv.dtype)
    o_c = jnp.einsum('bhqm,bhmd->bhqd', p_m, mkv[1]).transpose(0, 2, 1, 3).reshape(B, S, BRANCH_WIDTH)

    branches = jnp.stack([o_a, o_b, o_c], axis=2)
    branch_proj = jnp.einsum('bsnc,ncd->bsnd', branches, w_br)
    gates = jax.nn.sigmoid(gate_logit.reshape(B, S, N_BRANCHES, D_MODEL))
    merged = jnp.sum(gates * branch_proj, axis=2)
    return merged @ w_out


def setup_inputs(seed: int = 0) -> dict:
    key = jax.random.key(seed)
    ks = jax.random.split(key, 24)
    L = DEPTH

    def w(k, shape, fan_in, scale=1.0):
        return jax.random.normal(k, shape, jnp.float32) * (fan_in ** -0.5) * scale

    def gain(k, shape):
        return 1.0 + 0.02 * jax.random.normal(k, shape, jnp.float32)

    def bias(k, shape):
        return 0.02 * jax.random.normal(k, shape, jnp.float32)

    x = jax.random.normal(ks[0], (BATCH, SEQ, D_MODEL), jnp.float32)
    mem = jax.random.normal(ks[1], (BATCH, N_MEM, D_MODEL), jnp.float32)
    offsets = jax.random.randint(ks[2], (BATCH, 1), 0, 8192, dtype=jnp.int32)
    positions = offsets + jnp.arange(SEQ, dtype=jnp.int32)[None, :]
    return {
        'x': x,
        'mem': mem,
        'positions': positions,
        'ln_in_g': gain(ks[3], (D_MODEL,)),
        'ln_in_b': bias(ks[4], (D_MODEL,)),
        'w_in': w(ks[5], (L, D_MODEL, D_IN), D_MODEL),
        'b_forget': jax.random.uniform(ks[6], (L, FOX_HEADS), jnp.float32, 1.0, 6.0),
        'w_uq': w(ks[7], (L, MLA_Q_RANK, MLA_HEADS * (MLA_NOPE_DIM + MLA_ROPE_DIM)), MLA_Q_RANK),
        'g_cq': gain(ks[8], (L, MLA_Q_RANK)),
        'w_ukv': w(ks[9], (L, MLA_KV_RANK, MLA_HEADS * (MLA_NOPE_DIM + MLA_V_DIM)), MLA_KV_RANK),
        'g_ckv': gain(ks[10], (L, MLA_KV_RANK)),
        'w_mem_kv': w(ks[11], (L, D_MODEL, 2 * MEM_HEADS * MEM_HEAD_DIM), D_MODEL),
        'w_br': w(ks[12], (L, N_BRANCHES, BRANCH_WIDTH, D_MODEL), BRANCH_WIDTH, DEEPNORM_BETA),
        'w_out': w(ks[13], (L, D_MODEL, D_MODEL), D_MODEL, DEEPNORM_BETA),
        'ln1_g': gain(ks[14], (L, D_MODEL)),
        'ln1_b': bias(ks[15], (L, D_MODEL)),
        'w_ff1': w(ks[16], (L, D_MODEL, D_FF), D_MODEL),
        'w_ff2': w(ks[17], (L, D_FF, D_MODEL), D_FF, DEEPNORM_BETA),
        'ln2_g': gain(ks[18], (L, D_MODEL)),
        'ln2_b': bias(ks[19], (L, D_MODEL)),
    }


def reference(x, mem, positions, ln_in_g, ln_in_b, w_in, b_forget, w_uq, g_cq, w_ukv, g_ckv,
              w_mem_kv, w_br, w_out, ln1_g, ln1_b, w_ff1, w_ff2, ln2_g, ln2_b):
    cos, sin = _rope_tables(positions)
    h = _layer_norm(x, ln_in_g, ln_in_b)
    for l in range(DEPTH):
        y = _mixer(h, mem, cos, sin, w_in[l], b_forget[l], w_uq[l], g_cq[l], w_ukv[l], g_ckv[l],
                   w_mem_kv[l], w_br[l], w_out[l])
        h = _layer_norm(DEEPNORM_ALPHA * h + y, ln1_g[l], ln1_b[l])
        ff = jnp.square(jax.nn.relu(h @ w_ff1[l])) @ w_ff2[l]
        h = _layer_norm(DEEPNORM_ALPHA * h + ff, ln2_g[l], ln2_b[l])
    return h
```

```cpp
#include <hip/hip_runtime.h>
#include <hip/hip_cooperative_groups.h>
#include <cstdio>
#include <cstdint>
namespace cg = cooperative_groups;

#ifndef PROBE_DUP
#define PROBE_DUP 0
#endif
#ifndef MULTI_LAUNCH
#define MULTI_LAUNCH 0
#endif

typedef unsigned short bf16_t;
typedef short bf16x8 __attribute__((ext_vector_type(8)));
typedef short s16x4 __attribute__((ext_vector_type(4)));
typedef float f32x4 __attribute__((ext_vector_type(4)));
typedef float f32x16 __attribute__((ext_vector_type(16)));
typedef float f32x2_t __attribute__((ext_vector_type(2)));
typedef __bf16 bf16x2_t __attribute__((ext_vector_type(2)));
typedef __attribute__((address_space(3))) const char* lds_cptr;
typedef short v4i16_t __attribute__((ext_vector_type(4)));
typedef unsigned u32x4 __attribute__((ext_vector_type(4)));

#define DEV __device__ __forceinline__
#define LAS3 __attribute__((address_space(3)))
DEV int get_bx() { int t = blockIdx.x; asm volatile("" : "+s"(t)); return t; }
DEV int get_gx() { int t = gridDim.x; asm volatile("" : "+s"(t)); return t; }
DEV int get_tid() { int t = threadIdx.x; asm volatile("" : "+v"(t)); return t; }

constexpr int D = 1024, SEQ = 2048, NTOK = 32768, HTOK = 16384, DEPTH = 4, DINP = 5888, DFF = 4096, NMEM = 256;
constexpr float ALPHA = 1.6817928305074290f;
constexpr float LOG2E = 1.4426950408889634f;
constexpr float NEG = -1e30f;

constexpr size_t WO_IN = 0, WO_UQ = 6029312, WO_UKV = 6324224, WO_MKV = 6586368, WO_BR = 7634944, WO_OUT = 9207808,
                 WO_FF1 = 10256384, WO_FF2 = 14450688, WL = 18644992;
constexpr size_t OFF_CTRL = 0, CTRL_BYTES = 65536;
constexpr size_t OFF_WT = OFF_CTRL + CTRL_BYTES;
constexpr size_t OFF_HB = OFF_WT + WL * 2 * DEPTH;
constexpr size_t OFF_MKV = OFF_HB + (size_t)NTOK * D * 2;
constexpr size_t OFF_ROPE = OFF_MKV + (size_t)DEPTH * 4096 * 1024 * 2;
constexpr size_t OFF_REG = OFF_ROPE + (size_t)NTOK * 16 * 4 * 2;
constexpr size_t REG_BYTES = (size_t)NTOK * DFF * 2;
constexpr size_t OFF_XBUF = OFF_REG + REG_BYTES;
constexpr size_t WS_NEED = OFF_XBUF + (size_t)NTOK * 4 * 8 * 2;
constexpr size_t R_FOX = 0;
constexpr size_t R_CQ = R_FOX + (size_t)HTOK * 1536 * 2;
constexpr size_t R_CKV = R_CQ + (size_t)HTOK * 384 * 2;
constexpr size_t R_QMEM = R_CKV + (size_t)HTOK * 256 * 2;
constexpr size_t R_GATES = R_QMEM + (size_t)HTOK * 512 * 2;
constexpr size_t R_QB = R_GATES + (size_t)HTOK * 3072 * 2;
constexpr size_t R_KVB = R_QB + (size_t)HTOK * 768 * 2;
constexpr size_t R_OB = R_KVB + (size_t)HTOK * 1024 * 2;
constexpr size_t R_LOGF = R_OB + (size_t)HTOK * 512 * 2;
constexpr size_t R_CUMF = R_LOGF + (size_t)HTOK * 8 * 4;
constexpr size_t R_KPE = R_CUMF + (size_t)HTOK * 8 * 4;
constexpr size_t R_END = R_KPE + (size_t)HTOK * 32 * 2;
static_assert(R_END <= REG_BYTES, "region overflow");
constexpr int CT_BAR = 0, CT_QUEUE = 16, CT_LN = 64;

constexpr int GRP_LDS = 66048;
constexpr int XL_OFF = 131072;
constexpr int SMEM_BYTES = XL_OFF + 10240 + 1024;
constexpr int NSTEPS = 2 + DEPTH * 11;

struct Params {
  const float *x, *mem; const int* pos;
  const float *ln_in_g, *ln_in_b, *w_in, *b_forget, *w_uq, *g_cq, *w_ukv, *g_ckv, *w_mem_kv, *w_br, *w_out, *ln1_g, *ln1_b, *w_ff1, *w_ff2, *ln2_g, *ln2_b;
  float* out; char* ws;
};

DEV unsigned pk2(float lo, float hi) { f32x2_t v = {lo, hi}; bf16x2_t b = __builtin_convertvector(v, bf16x2_t); return __builtin_bit_cast(unsigned, b); }
DEV float bf_lo(unsigned u) { return __uint_as_float(u << 16); }
DEV float bf_hi(unsigned u) { return __uint_as_float(u & 0xffff0000u); }
DEV void st_bf4(bf16_t* p, f32x4 v) { uint2 w; w.x = pk2(v[0], v[1]); w.y = pk2(v[2], v[3]); *(uint2*)p = w; }
DEV float wave_sum(float v) {
  v += __shfl_xor(v, 32); v += __shfl_xor(v, 16); v += __shfl_xor(v, 8); v += __shfl_xor(v, 4); v += __shfl_xor(v, 2); v += __shfl_xor(v, 1); return v;
}
DEV float sigmoidf_(float x) { return 1.0f / (1.0f + __expf(-x)); }
DEV float log_sigmoidf_(float x) { return fminf(x, 0.f) - log1pf(expf(-fabsf(x))); }

DEV void grid_barrier(unsigned* ctr, unsigned nbar) {
  asm volatile("s_waitcnt vmcnt(0)" ::: "memory");
  __syncthreads();
  if (threadIdx.x == 0) {
    __builtin_amdgcn_fence(__ATOMIC_RELEASE, "agent");
    asm volatile("s_waitcnt vmcnt(0)" ::: "memory");
    __hip_atomic_fetch_add(ctr, 1u, __ATOMIC_RELAXED, __HIP_MEMORY_SCOPE_AGENT);
    const unsigned target = nbar * gridDim.x;
    while (__hip_atomic_load(ctr, __ATOMIC_RELAXED, __HIP_MEMORY_SCOPE_AGENT) < target) __builtin_amdgcn_s_sleep(4);
    __builtin_amdgcn_fence(__ATOMIC_ACQUIRE, "agent");
    asm volatile("s_waitcnt vmcnt(0)" ::: "memory");
  }
  __syncthreads();
}

namespace pg8 {
#define PG8_LAS __attribute__((address_space(3)))
typedef unsigned short bf16_t;
typedef short bf16x8 __attribute__((ext_vector_type(8)));
typedef float f32x4 __attribute__((ext_vector_type(4)));
typedef unsigned u32x4 __attribute__((ext_vector_type(4)));
constexpr int BM = 256, BK = 64, HALF = 128, HTB = HALF * BK * 2  , STAGE_BYTES = 8 * HTB, NXCD = 8, WGM = 8;

__host__ __device__ __forceinline__ int lds_byte(int r, int c) { const int st = (r >> 4) * 2 + (c >> 5), rr = r & 15, cc = c & 31, ob = rr * 64 + cc * 2; return st * 1024 + (ob ^ (((ob >> 9) & 1) << 5)); }
__host__ __device__ __forceinline__ void stage_rc(int b, int& R, int& C) { const int st = b / 1024, sb = b % 1024, swz = sb ^ (((sb >> 9) & 1) << 5); R = (st >> 1) * 16 + swz / 64; C = (st & 1) * 32 + (swz % 64) / 2; }
__host__ __device__ __forceinline__ int perm32(int rho) { const int n = rho >> 4, i = rho & 15; return 8 * (i >> 2) + 4 * n + (i & 3); }

struct Unit { int pm, pn; };
struct Gemm { const bf16_t* A; const bf16_t* Bt; int M, N, K; };

struct StaticOrder {
    int nM, nN, nwg, G, c;
    __host__ __device__ void init(int M, int N, int G_, int c_) { nM = M / BM; nN = N / BM; nwg = nM * nN; G = G_; c = c_; }
    __host__ __device__ bool next(int i, Unit& u) const {
        const long L = (long)i * G + c; if (L >= nwg) return false;
        int wgid = (int)L; { const int q = nwg / NXCD, r = nwg % NXCD, xcd = wgid % NXCD, off = wgid / NXCD; wgid = (xcd < r ? xcd * (q + 1) : r * (q + 1) + (xcd - r) * q) + off; }
        const int nig = WGM * nN, gid = wgid / nig, fm = gid * WGM, gsz = (nM - fm) < WGM ? (nM - fm) : WGM;
        u.pm = fm + ((wgid % nig) % gsz); u.pn = (wgid % nig) / gsz; return true;
    }
    __device__ __forceinline__ void a_ready(const Unit&) const {}
    __device__ __forceinline__ void done(const Unit&) const {}
};


template <class Epi, class Sched, bool ALIGN_EPI = false, bool SP2 = false>
__device__ __forceinline__ void gemm_phase(PG8_LAS unsigned char* lds, const Gemm g, const Sched& S, const Epi& E) {
    const int tid = get_tid(), wid = __builtin_amdgcn_readfirstlane(tid >> 6), lane = tid & 63, wr = wid >> 2, wc = wid & 3, fr = lane & 15, fq = lane >> 4;
    const int K = g.K, nt = K / BK;
    unsigned voffA[2], voffB[2];
#pragma unroll
    for (int i = 0; i < 2; ++i) { int R, C; stage_rc(tid * 16 + i * 8192, R, C); const int Rb = Epi::PERM ? ((R & ~31) + perm32(R & 31)) : R;
        voffA[i] = (unsigned)(R * K + C) * 2u; voffB[i] = (unsigned)(Rb * K + C) * 2u; }
    const size_t kstep = (size_t)(BK * 2);
    const size_t hstep = (size_t)HALF * K * 2;
    const size_t tstep = 2 * hstep;
    const unsigned ldsw = (unsigned)wid * 1024u;
    const int aoff = lds_byte(wr * 64 + fr, fq * 8), boff = lds_byte(wc * 32 + fr, fq * 8);
#define PG8_SA(b, h) (((b) * 2 + (h)) * HTB)
#define PG8_SB(b, h) ((4 + (b) * 2 + (h)) * HTB)
#define PG8_STAGE(bufoff, gbase, voff) do { _Pragma("unroll") for (int _i = 0; _i < 2; ++_i) \
        __builtin_amdgcn_global_load_lds((const unsigned*)((const char*)(gbase) + (voff)[_i]), (PG8_LAS unsigned*)(lds + (bufoff) + ldsw + _i * 8192), 16, 0, 0); } while (0)
#define PG8_LDA(dst, b, h) do { _Pragma("unroll") for (int m = 0; m < 4; ++m) _Pragma("unroll") for (int k = 0; k < 2; ++k) dst[m][k] = *(const PG8_LAS bf16x8*)(lds + PG8_SA(b, h) + aoff + m * 2048 + k * 1024); } while (0)
#define PG8_LDB(dst, b, h) do { _Pragma("unroll") for (int n = 0; n < 2; ++n) _Pragma("unroll") for (int k = 0; k < 2; ++k) dst[n][k] = *(const PG8_LAS bf16x8*)(lds + PG8_SB(b, h) + boff + n * 2048 + k * 1024); } while (0)
#define PG8_MMA(ai, bj, At, Bt) do { __builtin_amdgcn_s_setprio(1); _Pragma("unroll") for (int m = 0; m < 4; ++m) _Pragma("unroll") for (int n = 0; n < 2; ++n) _Pragma("unroll") for (int k = 0; k < 2; ++k) \
        acc[ai][bj][m][n] = __builtin_amdgcn_mfma_f32_16x16x32_bf16(Bt[n][k], At[m][k], acc[ai][bj][m][n], 0, 0, 0); __builtin_amdgcn_s_setprio(0); } while (0)
#define PG8_WAIT_V(n) asm volatile("s_waitcnt vmcnt(" #n ")" ::: "memory")
#define PG8_WAIT_L(n) asm volatile("s_waitcnt lgkmcnt(" #n ")" ::: "memory")
#define PG8_BAR __builtin_amdgcn_s_barrier()
#define PG8_SCHED __builtin_amdgcn_sched_barrier(0)
    Unit cur, nxt; int ui = 0;
    if (!S.next(0, cur)) return;
    f32x4 acc[2][2][4][2];
#pragma unroll
    for (int a = 0; a < 2; ++a)
#pragma unroll
        for (int b = 0; b < 2; ++b)
#pragma unroll
            for (int m = 0; m < 4; ++m)
#pragma unroll
                for (int n = 0; n < 2; ++n) acc[a][b][m][n] = (f32x4){0.f, 0.f, 0.f, 0.f};
    bf16x8 At[4][2], B0[2][2], B1[2][2];
    const char* cA = (const char*)g.A + (size_t)cur.pm * tstep; const char* cB = (const char*)g.Bt + (size_t)cur.pn * tstep;
    S.a_ready(cur);
    if constexpr (SP2) {
        PG8_STAGE(PG8_SB(0, 0), cB, voffB); PG8_STAGE(PG8_SB(0, 1), cB + hstep, voffB); PG8_STAGE(PG8_SA(0, 0), cA, voffA); PG8_STAGE(PG8_SA(0, 1), cA + hstep, voffA);
        if (wr == 1) PG8_BAR;
        PG8_WAIT_V(2); PG8_BAR;
        PG8_STAGE(PG8_SB(1, 0), cB + kstep, voffB); PG8_STAGE(PG8_SA(1, 0), cA + kstep, voffA); PG8_STAGE(PG8_SB(1, 1), cB + hstep + kstep, voffB);
        PG8_WAIT_V(6); PG8_BAR;
    } else {
        PG8_STAGE(PG8_SB(0, 0), cB, voffB); PG8_STAGE(PG8_SA(0, 0), cA, voffA); PG8_STAGE(PG8_SB(0, 1), cB + hstep, voffB); PG8_STAGE(PG8_SA(0, 1), cA + hstep, voffA);
        if (wr == 1) PG8_BAR;
        PG8_WAIT_V(4); PG8_BAR;
        PG8_STAGE(PG8_SB(1, 0), cB + kstep, voffB); PG8_STAGE(PG8_SA(1, 0), cA + kstep, voffA); PG8_STAGE(PG8_SB(1, 1), cB + hstep + kstep, voffB);
        PG8_WAIT_V(6); PG8_BAR;
    }
    for (;;) {
        const bool has_next = S.next(ui + 1, nxt);
        const char* nA = has_next ? (const char*)g.A + (size_t)nxt.pm * tstep : cA; const char* nB = has_next ? (const char*)g.Bt + (size_t)nxt.pn * tstep : cB;
        for (int t = 0; t < nt; t += 2) {
            const bool last = (t == nt - 2);
            const char* a1 = cA + (size_t)(t + 1) * kstep;
            const char* a2 = last ? nA : cA + (size_t)(t + 2) * kstep; const char* b2 = last ? nB : cB + (size_t)(t + 2) * kstep;
            const char* a3 = a2 + kstep; const char* b3 = b2 + kstep;
            if (last && has_next) S.a_ready(nxt);
            if constexpr (SP2) {
            PG8_LDB(B0, 0, 0); PG8_LDB(B1, 0, 1); PG8_SCHED; PG8_LDA(At, 0, 0); PG8_STAGE(PG8_SA(1, 1), a1 + hstep, voffA);
            PG8_WAIT_V(8); PG8_WAIT_L(0); PG8_BAR; PG8_MMA(0, 0, At, B0); PG8_MMA(0, 1, At, B1); PG8_BAR; PG8_SCHED;
            PG8_LDA(At, 0, 1); PG8_STAGE(PG8_SB(0, 0), b2, voffB); PG8_STAGE(PG8_SB(0, 1), b2 + hstep, voffB); PG8_STAGE(PG8_SA(0, 0), a2, voffA);
            PG8_WAIT_V(8); PG8_WAIT_L(0); PG8_BAR; PG8_MMA(1, 0, At, B0); PG8_MMA(1, 1, At, B1); PG8_BAR; PG8_SCHED;
            PG8_LDB(B0, 1, 0); PG8_LDB(B1, 1, 1); PG8_SCHED; PG8_LDA(At, 1, 0); PG8_STAGE(PG8_SA(0, 1), a2 + hstep, voffA);
            PG8_WAIT_V(8); PG8_WAIT_L(0); PG8_BAR; PG8_MMA(0, 0, At, B0); PG8_MMA(0, 1, At, B1); PG8_BAR; PG8_SCHED;
            PG8_LDA(At, 1, 1); PG8_STAGE(PG8_SB(1, 0), b3, voffB); PG8_STAGE(PG8_SB(1, 1), b3 + hstep, voffB); PG8_STAGE(PG8_SA(1, 0), a3, voffA);
            PG8_WAIT_V(8); PG8_WAIT_L(0); PG8_BAR; PG8_MMA(1, 0, At, B0); PG8_MMA(1, 1, At, B1); PG8_BAR; PG8_SCHED;
            } else {
            PG8_LDB(B0, 0, 0); PG8_SCHED; PG8_LDA(At, 0, 0); PG8_STAGE(PG8_SA(1, 1), a1 + hstep, voffA);
            PG8_WAIT_L(8); PG8_BAR; PG8_WAIT_L(0); PG8_MMA(0, 0, At, B0); PG8_BAR; PG8_SCHED;
            PG8_LDB(B1, 0, 1); PG8_STAGE(PG8_SB(0, 0), b2, voffB);
            PG8_BAR; PG8_WAIT_L(0); PG8_MMA(0, 1, At, B1); PG8_BAR;
            PG8_LDA(At, 0, 1); PG8_STAGE(PG8_SA(0, 0), a2, voffA);
            PG8_BAR; PG8_WAIT_L(0); PG8_MMA(1, 0, At, B0); PG8_BAR; PG8_SCHED;
            PG8_STAGE(PG8_SB(0, 1), b2 + hstep, voffB);
            PG8_WAIT_V(6); PG8_BAR; PG8_MMA(1, 1, At, B1); PG8_BAR;
            PG8_LDB(B0, 1, 0); PG8_SCHED; PG8_LDA(At, 1, 0); PG8_STAGE(PG8_SA(0, 1), a2 + hstep, voffA);
            PG8_WAIT_L(8); PG8_BAR; PG8_WAIT_L(0); PG8_MMA(0, 0, At, B0); PG8_BAR; PG8_SCHED;
            PG8_LDB(B1, 1, 1); PG8_STAGE(PG8_SB(1, 0), b3, voffB);
            PG8_BAR; PG8_WAIT_L(0); PG8_MMA(0, 1, At, B1); PG8_BAR;
            PG8_LDA(At, 1, 1); PG8_STAGE(PG8_SA(1, 0), a3, voffA);
            PG8_BAR; PG8_WAIT_L(0); PG8_MMA(1, 0, At, B0); PG8_BAR; PG8_SCHED;
            PG8_STAGE(PG8_SB(1, 1), b3 + hstep, voffB);
            PG8_WAIT_V(6); PG8_BAR; PG8_MMA(1, 1, At, B1); PG8_BAR;
            }
        }
        if constexpr (ALIGN_EPI) { if (wr == 0) PG8_BAR; }
        if constexpr (!Epi::AFTER_DRAIN) { E(acc, cur, wr, wc, fr, fq); S.done(cur); }
        if (!has_next) break;
#pragma unroll
        for (int a = 0; a < 2; ++a)
#pragma unroll
            for (int b = 0; b < 2; ++b)
#pragma unroll
                for (int m = 0; m < 4; ++m)
#pragma unroll
                    for (int n = 0; n < 2; ++n) acc[a][b][m][n] = (f32x4){0.f, 0.f, 0.f, 0.f};
        cur = nxt; cA = nA; cB = nB; ++ui;
        if constexpr (ALIGN_EPI) { if (wr == 1) PG8_BAR; }
    }
    PG8_WAIT_V(0);
    if constexpr (!ALIGN_EPI) { if (wr == 0) PG8_BAR; }
    PG8_BAR;
    if constexpr (Epi::AFTER_DRAIN) { E.fused(acc, cur, wr, wc, fr, fq, lds, wid, lane); S.done(cur); }
#undef PG8_SA
#undef PG8_SB
#undef PG8_STAGE
#undef PG8_LDA
#undef PG8_LDB
#undef PG8_MMA
#undef PG8_WAIT_V
#undef PG8_WAIT_L
#undef PG8_BAR
#undef PG8_SCHED
}
}

template <bool ROWSS>
DEV void gemm_main(int tid, const bf16_t* __restrict__ A, int lda, const bf16_t* __restrict__ Bt, int ldb, int K, char* lds, f32x4 (&acc)[4][4], float* rowss) {
  const int lane = tid & 63, wid = tid >> 6, wm = wid >> 1, wn = wid & 1, fr = lane & 15, fq = lane >> 4;
  const int lc = tid & 7, lr = tid >> 3;
  const int st_off = lr * 128 + ((lc ^ ((lr >> 1) & 7)) << 4);
  const bf16_t* ap = A + (size_t)lr * lda + lc * 8;
  const bf16_t* bp = Bt + (size_t)lr * ldb + lc * 8;
  const int sw = (fr >> 1) & 7;
  const int a_rd = (wm * 64 + fr) * 128, b_rd = (wn * 64 + fr) * 128;
  u32x4 ra[4], rb[4];
  float ss[4] = {0.f, 0.f, 0.f, 0.f};
  const int nk = K >> 6;
#pragma unroll
  for (int i = 0; i < 4; ++i) { ra[i] = *(const u32x4*)(ap + (size_t)(32 * i) * lda); rb[i] = *(const u32x4*)(bp + (size_t)(32 * i) * ldb); }
#pragma unroll
  for (int i = 0; i < 4; ++i) {
    *(u32x4*)(lds + st_off + i * 4096) = ra[i]; *(u32x4*)(lds + 32768 + st_off + i * 4096) = rb[i];
    if (ROWSS) {
#pragma unroll
      for (int e = 0; e < 4; ++e) { const float a = bf_lo(ra[i][e]), b = bf_hi(ra[i][e]); ss[i] += a * a + b * b; } }
  }
  __syncthreads();
#pragma unroll 1
  for (int kt = 0; kt < nk; ++kt) {
    const bool more = (kt + 1 < nk);
    if (more) {
      const int k0 = (kt + 1) << 6;
#pragma unroll
      for (int i = 0; i < 4; ++i) { ra[i] = *(const u32x4*)(ap + (size_t)(32 * i) * lda + k0); rb[i] = *(const u32x4*)(bp + (size_t)(32 * i) * ldb + k0); }
    }
    const char* as = lds + (kt & 1) * 16384;
    const char* bs = lds + 32768 + (kt & 1) * 16384;
#pragma unroll
    for (int kk = 0; kk < 2; ++kk) {
      bf16x8 af[4], bf[4];
      const int co = ((kk * 4 + fq) ^ sw) << 4;
#pragma unroll
      for (int m = 0; m < 4; ++m) af[m] = *(const bf16x8*)(as + a_rd + m * 2048 + co);
#pragma unroll
      for (int n = 0; n < 4; ++n) bf[n] = *(const bf16x8*)(bs + b_rd + n * 2048 + co);
#pragma unroll
      for (int m = 0; m < 4; ++m)
#pragma unroll
        for (int n = 0; n < 4; ++n) acc[m][n] = __builtin_amdgcn_mfma_f32_16x16x32_bf16(bf[n], af[m], acc[m][n], 0, 0, 0);
    }
    if (more) {
      char* ad = lds + ((kt + 1) & 1) * 16384; char* bd = lds + 32768 + ((kt + 1) & 1) * 16384;
#pragma unroll
      for (int i = 0; i < 4; ++i) {
        *(u32x4*)(ad + st_off + i * 4096) = ra[i]; *(u32x4*)(bd + st_off + i * 4096) = rb[i];
        if (ROWSS) {
#pragma unroll
          for (int e = 0; e < 4; ++e) { const float a = bf_lo(ra[i][e]), b = bf_hi(ra[i][e]); ss[i] += a * a + b * b; } }
      }
    }
    __syncthreads();
  }
  if (ROWSS) {
#pragma unroll
    for (int i = 0; i < 4; ++i) { float v = ss[i]; v += __shfl_xor(v, 1); v += __shfl_xor(v, 2); v += __shfl_xor(v, 4); if (lc == 0) rowss[lr + 32 * i] = v; }
    __syncthreads();
  }
}

DEV void gemm_glds(int tid, const bf16_t* __restrict__ A, int lda, const bf16_t* __restrict__ Bt, int ldb, int K, char* lds, f32x4 (&acc)[4][4]) {
  const int lane = tid & 63, wid = __builtin_amdgcn_readfirstlane(tid >> 6), wm = wid >> 1, wn = wid & 1, fr = lane & 15, fq = lane >> 4;
  const int srow = wid * 8 + (lane >> 3);
  const int lchunk = (lane & 7) ^ ((4 * (wid & 1) + (lane >> 4)) & 7);
  const bf16_t* ap = A + (size_t)srow * lda + lchunk * 8;
  const bf16_t* bp = Bt + (size_t)srow * ldb + lchunk * 8;
  const int sw = (fr >> 1) & 7;
  const int a_rd = (wm * 64 + fr) * 128, b_rd = (wn * 64 + fr) * 128;
  const int nk = K >> 6;
  LAS3 char* l3 = (LAS3 char*)lds + wid * 1024;
#define GLDS_TILE(buf, k0)                                                                                              \
  do {                                                                                                                  \
    _Pragma("unroll") for (int i = 0; i < 4; ++i) {                                                                     \
      __builtin_amdgcn_global_load_lds((const unsigned*)(ap + (size_t)(32 * i) * lda + (k0)), (LAS3 unsigned*)(l3 + (buf) * 16384 + i * 4096), 16, 0, 0);          \
      __builtin_amdgcn_global_load_lds((const unsigned*)(bp + (size_t)(32 * i) * ldb + (k0)), (LAS3 unsigned*)(l3 + 32768 + (buf) * 16384 + i * 4096), 16, 0, 0);  \
    }                                                                                                                   \
  } while (0)
  GLDS_TILE(0, 0);
  asm volatile("s_waitcnt vmcnt(0)" ::: "memory");
  __syncthreads();
#pragma unroll 1
  for (int kt = 0; kt < nk; ++kt) {
    if (kt + 1 < nk) GLDS_TILE((kt + 1) & 1, (kt + 1) << 6);
    const char* as = lds + (kt & 1) * 16384;
    const char* bs = lds + 32768 + (kt & 1) * 16384;
#pragma unroll
    for (int kk = 0; kk < 2; ++kk) {
      bf16x8 af[4], bf[4];
      const int co = ((kk * 4 + fq) ^ sw) << 4;
#pragma unroll
      for (int m = 0; m < 4; ++m) af[m] = *(const bf16x8*)(as + a_rd + m * 2048 + co);
#pragma unroll
      for (int n = 0; n < 4; ++n) bf[n] = *(const bf16x8*)(bs + b_rd + n * 2048 + co);
#pragma unroll
      for (int m = 0; m < 4; ++m)
#pragma unroll
        for (int n = 0; n < 4; ++n) acc[m][n] = __builtin_amdgcn_mfma_f32_16x16x32_bf16(bf[n], af[m], acc[m][n], 0, 0, 0);
    }
    asm volatile("s_waitcnt vmcnt(0)" ::: "memory");
    __syncthreads();
  }
#undef GLDS_TILE
}

DEV void zero_acc(f32x4 (&acc)[4][4]) {
#pragma unroll
  for (int m = 0; m < 4; ++m)
#pragma unroll
    for (int n = 0; n < 4; ++n) acc[m][n] = (f32x4){0.f, 0.f, 0.f, 0.f};
}

DEV int gemm_iters(int vgrid, int nRB, int nCT) { const int nj = vgrid >> 3, sc = nj >> 3, rpx = nRB >> 3; return ((rpx + 7) >> 3) * ((nCT + sc - 1) / sc); }
DEV bool gemm_sched(int vb, int vgrid, int it, int nRB, int nCT, int& rb, int& ct) {
  const int xcd = (vb >> 1) & 7, j = ((vb >> 4) << 1) | (vb & 1), nj = vgrid >> 3, sc = nj >> 3, rpx = nRB >> 3;
  const int nRS = (rpx + 7) >> 3;
  const int rs = it % nRS, cs = it / nRS;
  const int rloc = rs * 8 + (j & 7), c = cs * sc + (j >> 3);
  rb = xcd * rpx + rloc; ct = c;
  return (rloc < rpx) && (c < nCT);
}

DEV void ln_panel(int tid, float* h, bf16_t* hb, int grow0, const float* __restrict__ g, const float* __restrict__ b) {
  const int lane = tid & 63, wid = tid >> 6;
  f32x4 gv[4], bv[4];
#pragma unroll
  for (int i = 0; i < 4; ++i) { gv[i] = *(const f32x4*)(g + lane * 4 + 256 * i); bv[i] = *(const f32x4*)(b + lane * 4 + 256 * i); }
#pragma unroll 2
  for (int r = 0; r < 32; ++r) {
    const size_t row = (size_t)(grow0 + wid * 32 + r);
    float* hp = h + row * D + lane * 4;
    f32x4 v[4];
#pragma unroll
    for (int i = 0; i < 4; ++i) v[i] = *(const f32x4*)(hp + 256 * i);
    float s = 0.f;
#pragma unroll
    for (int i = 0; i < 4; ++i) s += (v[i][0] + v[i][1]) + (v[i][2] + v[i][3]);
    const float mean = wave_sum(s) * (1.0f / 1024.0f);
    float q = 0.f;
#pragma unroll
    for (int i = 0; i < 4; ++i) { v[i] = v[i] - mean; q += (v[i][0] * v[i][0] + v[i][1] * v[i][1]) + (v[i][2] * v[i][2] + v[i][3] * v[i][3]); }
    const float rstd = rsqrtf(wave_sum(q) * (1.0f / 1024.0f) + 1e-5f);
    bf16_t* bp = hb + row * D + lane * 4;
#pragma unroll
    for (int i = 0; i < 4; ++i) { const f32x4 y = v[i] * rstd * gv[i] + bv[i]; *(f32x4*)(hp + 256 * i) = y; st_bf4(bp + 256 * i, y); }
  }
}

DEV void ln_rows64(int tid, float* h, bf16_t* hb, int grow0, const float* __restrict__ g, const float* __restrict__ b) {
  const int lane = tid & 63, wid = tid >> 6;
  f32x4 gv[4], bv[4];
#pragma unroll
  for (int i = 0; i < 4; ++i) { gv[i] = *(const f32x4*)(g + lane * 4 + 256 * i); bv[i] = *(const f32x4*)(b + lane * 4 + 256 * i); }
#pragma unroll 1
  for (int bt = 0; bt < 2; ++bt) {
    const size_t row0 = (size_t)(grow0 + wid * 8 + bt * 4);
    f32x4 v[4][4];
#pragma unroll
    for (int j = 0; j < 4; ++j)
#pragma unroll
      for (int i = 0; i < 4; ++i) v[j][i] = *(const f32x4*)(h + (row0 + j) * D + lane * 4 + 256 * i);
#pragma unroll
    for (int j = 0; j < 4; ++j) {
      float s = 0.f;
#pragma unroll
      for (int i = 0; i < 4; ++i) s += (v[j][i][0] + v[j][i][1]) + (v[j][i][2] + v[j][i][3]);
      const float mean = wave_sum(s) * (1.0f / 1024.0f);
      float q = 0.f;
#pragma unroll
      for (int i = 0; i < 4; ++i) { v[j][i] = v[j][i] - mean; q += (v[j][i][0] * v[j][i][0] + v[j][i][1] * v[j][i][1]) + (v[j][i][2] * v[j][i][2] + v[j][i][3] * v[j][i][3]); }
      const float rstd = rsqrtf(wave_sum(q) * (1.0f / 1024.0f) + 1e-5f);
      float* hp = h + (row0 + j) * D + lane * 4; bf16_t* bp = hb + (row0 + j) * D + lane * 4;
#pragma unroll
      for (int i = 0; i < 4; ++i) { const f32x4 y = v[j][i] * rstd * gv[i] + bv[i]; *(f32x4*)(hp + 256 * i) = y; st_bf4(bp + 256 * i, y); }
    }
  }
}

DEV int win_src(int n) {
  if (n < 1536) return n;
  if (n < 1920) return n - 1536 + 1544;
  if (n < 2176) return n - 1920 + 1928;
  if (n < 2688) return n - 2176 + 2216;
  if (n < 5760) return n - 2688 + 2728;
  const int r = n - 5760;
  if (r < 32) return 2184 + r;
  if (r >= 64 && r < 72) return 1536 + (r - 64);
  return -1;
}
DEV void transpose_tile(int tid, bool valid, const float* __restrict__ src, int ldsrc, int K, bf16_t* __restrict__ dst, int n0, int k0, bool winmap, const float* __restrict__ kscale, char* lds) {
  float* t = (float*)lds;
  const int tx = tid & 63, ty = tid >> 6;
  const int n = n0 + tx; const int sc = winmap ? win_src(n) : n;
  if (valid) {
#pragma unroll 4
    for (int i = 0; i < 16; ++i) { const int kk = ty + 4 * i; float v = 0.f; if (sc >= 0) { v = src[(size_t)(k0 + kk) * ldsrc + sc]; if (kscale) v *= kscale[k0 + kk]; } t[kk * 65 + tx] = v; }
  }
  __syncthreads();
  if (valid) {
#pragma unroll
    for (int i = 0; i < 2; ++i) { const int q = tid + 256 * i, nn = q >> 3, c = q & 7; u32x4 w;
      w[0] = pk2(t[(c * 8 + 0) * 65 + nn], t[(c * 8 + 1) * 65 + nn]); w[1] = pk2(t[(c * 8 + 2) * 65 + nn], t[(c * 8 + 3) * 65 + nn]);
      w[2] = pk2(t[(c * 8 + 4) * 65 + nn], t[(c * 8 + 5) * 65 + nn]); w[3] = pk2(t[(c * 8 + 6) * 65 + nn], t[(c * 8 + 7) * 65 + nn]);
      *(u32x4*)(dst + (size_t)(n0 + nn) * K + k0 + c * 8) = w; }
  }
  __syncthreads();
}
template <int DQK, int DV, int MODE>
DEV void attn_unit(int tid, const bf16_t* Qp, int ldq, const bf16_t* __restrict__ K1p, int ldk1, const bf16_t* __restrict__ K2p,
                   const bf16_t* __restrict__ Vp, int ldv, bf16_t* Op, int ldo, const float* __restrict__ Fp, int qb, float sc2, char* lds) {
  constexpr int KS = DQK * 2 + 16, VS = DV * 2 + 64, KC = DQK / 8, VC = DV / 8, NKL = 64 * KC / 256, NVL = 64 * VC / 256;
  constexpr int NKS = DQK / 16, NDB = DV / 32;
  const int lane = tid & 63, w = tid >> 6, r32 = lane & 31, hi = lane >> 5;
  char* Kb = lds; char* Vb = lds + 2 * 64 * KS; float* Fb = (float*)(lds + 2 * 64 * KS + 2 * 64 * VS);
  const int nt = (MODE == 2) ? 4 : 2 * qb + 2;
  const int ntw = (MODE == 2) ? 4 : 2 * qb + 1 + (w >> 1);
  const int qrow = 128 * qb + 32 * w + r32;

  u32x4 kreg[2][NKL], vreg[2][NVL]; float freg[2] = {0.f, 0.f};
#define ATT_GLOAD(t, S_)                                                                                                      \
  do {                                                                                                                        \
    _Pragma("unroll") for (int i = 0; i < NKL; ++i) { const int q = tid + 256 * i, row = q / KC, c = q % KC; const size_t key = (size_t)(64 * (t) + row); \
      if (MODE == 1 && c >= 8) kreg[S_][i] = *(const u32x4*)(K2p + key * 32 + (c - 8) * 8); else kreg[S_][i] = *(const u32x4*)(K1p + key * ldk1 + c * 8); } \
    _Pragma("unroll") for (int i = 0; i < NVL; ++i) { const int q = tid + 256 * i, row = q / VC, c = q % VC; vreg[S_][i] = *(const u32x4*)(Vp + (size_t)(64 * (t) + row) * ldv + c * 8); } \
    if (MODE == 0) freg[S_] = Fp[(size_t)(64 * (t) + (tid & 63)) * 8];                                                       \
  } while (0)
#define ATT_LSTORE(buf, S_)                                                                                                   \
  do {                                                                                                                        \
    _Pragma("unroll") for (int i = 0; i < NKL; ++i) { const int q = tid + 256 * i, row = q / KC, c = q % KC; *(u32x4*)(Kb + (buf) * 64 * KS + row * KS + c * 16) = kreg[S_][i]; } \
    _Pragma("unroll") for (int i = 0; i < NVL; ++i) { const int q = tid + 256 * i, row = q / VC, c = q % VC; *(u32x4*)(Vb + (buf) * 64 * VS + row * VS + c * 16) = vreg[S_][i]; } \
    if (MODE == 0 && tid < 64) Fb[(buf) * 64 + tid] = -freg[S_] * LOG2E;                                                      \
  } while (0)

  ATT_GLOAD(0, 0);
  ATT_GLOAD(1, 1);
  bf16x8 qf[NKS];
#pragma unroll
  for (int ks = 0; ks < NKS; ++ks) qf[ks] = *(const bf16x8*)(Qp + (size_t)qrow * ldq + ks * 16 + hi * 8);
  ATT_LSTORE(0, 0);
  __syncthreads();

  f32x16 o[NDB];
#pragma unroll
  for (int db = 0; db < NDB; ++db)
#pragma unroll
    for (int r = 0; r < 16; ++r) o[db][r] = 0.f;
  float mrun = NEG, lsum = 0.f;
  const int k_rd = r32 * KS + hi * 16;
  const int v_rd = (4 * hi + ((lane & 15) >> 2)) * VS + (16 * ((lane >> 4) & 1) + 4 * (lane & 3)) * 2;

#pragma unroll 1
  for (int t2 = 0; t2 < nt; t2 += 2) {
#pragma unroll
    for (int par = 0; par < 2; ++par) {
      const int t = t2 + par;
      { const int tl = (t + 2 < nt) ? t + 2 : nt - 1; ATT_GLOAD(tl, par); }
    if (t < ntw) {
      const char* kt = Kb + par * 64 * KS + k_rd;
      f32x16 s0, s1;
#pragma unroll
      for (int r = 0; r < 16; ++r) { s0[r] = 0.f; s1[r] = 0.f; }
#pragma unroll
      for (int ks = 0; ks < NKS; ++ks) {
        const bf16x8 k0 = *(const bf16x8*)(kt + ks * 32);
        const bf16x8 k1 = *(const bf16x8*)(kt + 32 * KS + ks * 32);
        s0 = __builtin_amdgcn_mfma_f32_32x32x16_bf16(k0, qf[ks], s0, 0, 0, 0);
        s1 = __builtin_amdgcn_mfma_f32_32x32x16_bf16(k1, qf[ks], s1, 0, 0, 0);
      }
      f32x2_t psum2 = {0.f, 0.f};
      float alpha;
      if (MODE == 0) {
        const float* fb = Fb + par * 64 + 4 * hi;
        const f32x2_t sc2v = {sc2, sc2};
#pragma unroll
        for (int g = 0; g < 4; ++g) {
          const f32x4 f0 = *(const f32x4*)(fb + 8 * g), f1 = *(const f32x4*)(fb + 32 + 8 * g);
#pragma unroll
          for (int e = 0; e < 4; e += 2) {
            const f32x2_t a0 = (f32x2_t){s0[4 * g + e], s0[4 * g + e + 1]} * sc2v + (f32x2_t){f0[e], f0[e + 1]};
            const f32x2_t a1 = (f32x2_t){s1[4 * g + e], s1[4 * g + e + 1]} * sc2v + (f32x2_t){f1[e], f1[e + 1]};
            s0[4 * g + e] = a0[0]; s0[4 * g + e + 1] = a0[1]; s1[4 * g + e] = a1[0]; s1[4 * g + e + 1] = a1[1];
          }
        }
        if (t >= 2 * qb) {
          const int qrel = 32 * w + r32, kb0 = 64 * (t - 2 * qb) + 4 * hi;
#pragma unroll
          for (int r = 0; r < 16; ++r) { const int kr = kb0 + (r & 3) + 8 * (r >> 2); if (kr > qrel) s0[r] = NEG; if (kr + 32 > qrel) s1[r] = NEG; }
        }
      }
      float mx = fmaxf(s0[0], s1[0]);
#pragma unroll
      for (int r = 1; r < 16; ++r) mx = fmaxf(mx, fmaxf(s0[r], s1[r]));
      mx = fmaxf(mx, __shfl_xor(mx, 32));
      const float mnew = fmaxf(mrun, mx);
      const bool grew = mnew > mrun;
      if (MODE == 0) {
        alpha = __builtin_amdgcn_exp2f(mrun - mnew);
        const f32x2_t nm = {-mnew, -mnew};
#pragma unroll
        for (int r = 0; r < 16; r += 2) {
          const f32x2_t a0 = (f32x2_t){s0[r], s0[r + 1]} + nm, a1 = (f32x2_t){s1[r], s1[r + 1]} + nm;
          const f32x2_t p0 = {__builtin_amdgcn_exp2f(a0[0]), __builtin_amdgcn_exp2f(a0[1])}, p1 = {__builtin_amdgcn_exp2f(a1[0]), __builtin_amdgcn_exp2f(a1[1])};
          s0[r] = p0[0]; s0[r + 1] = p0[1]; s1[r] = p1[0]; s1[r + 1] = p1[1];
          psum2 += p0; psum2 += p1;
        }
      } else {
        alpha = __builtin_amdgcn_exp2f((mrun - mnew) * sc2);
        const float nms = -mnew * sc2;
        const f32x2_t nm = {nms, nms}, sc2v = {sc2, sc2};
#pragma unroll
        for (int r = 0; r < 16; r += 2) {
          const f32x2_t a0 = (f32x2_t){s0[r], s0[r + 1]} * sc2v + nm, a1 = (f32x2_t){s1[r], s1[r + 1]} * sc2v + nm;
          const f32x2_t p0 = {__builtin_amdgcn_exp2f(a0[0]), __builtin_amdgcn_exp2f(a0[1])}, p1 = {__builtin_amdgcn_exp2f(a1[0]), __builtin_amdgcn_exp2f(a1[1])};
          s0[r] = p0[0]; s0[r + 1] = p0[1]; s1[r] = p1[0]; s1[r + 1] = p1[1];
          psum2 += p0; psum2 += p1;
        }
      }
      mrun = mnew;
      lsum = lsum * alpha + (psum2[0] + psum2[1]);
      if (__builtin_amdgcn_ballot_w64(grew) != 0ull) {
#pragma unroll
        for (int db = 0; db < NDB; ++db)
#pragma unroll
          for (int r = 0; r < 16; ++r) o[db][r] *= alpha;
      }
      const lds_cptr vt = (lds_cptr)(Vb + par * 64 * VS + v_rd);
#pragma unroll
      for (int kb = 0; kb < 2; ++kb)
#pragma unroll
        for (int s = 0; s < 2; ++s) {
          u32x4 pu;
          if (kb == 0) pu = (u32x4){pk2(s0[8 * s + 0], s0[8 * s + 1]), pk2(s0[8 * s + 2], s0[8 * s + 3]), pk2(s0[8 * s + 4], s0[8 * s + 5]), pk2(s0[8 * s + 6], s0[8 * s + 7])};
          else         pu = (u32x4){pk2(s1[8 * s + 0], s1[8 * s + 1]), pk2(s1[8 * s + 2], s1[8 * s + 3]), pk2(s1[8 * s + 4], s1[8 * s + 5]), pk2(s1[8 * s + 6], s1[8 * s + 7])};
          const bf16x8 pfv = __builtin_bit_cast(bf16x8, pu);
#pragma unroll
          for (int db = 0; db < NDB; ++db) {
            const lds_cptr vp = vt + (32 * kb + 16 * s) * VS + db * 64;
            const s16x4 lo = __builtin_bit_cast(s16x4, __builtin_amdgcn_ds_read_tr16_b64_v4i16((__attribute__((address_space(3))) v4i16_t*)vp));
            const s16x4 hh = __builtin_bit_cast(s16x4, __builtin_amdgcn_ds_read_tr16_b64_v4i16((__attribute__((address_space(3))) v4i16_t*)(vp + 8 * VS)));
            const bf16x8 vf = (bf16x8){lo[0], lo[1], lo[2], lo[3], hh[0], hh[1], hh[2], hh[3]};
            o[db] = __builtin_amdgcn_mfma_f32_32x32x16_bf16(vf, pfv, o[db], 0, 0, 0);
          }
        }
    }
      ATT_LSTORE(par ^ 1, par ^ 1);
      __syncthreads();
    }
  }
#undef ATT_GLOAD
#undef ATT_LSTORE
  const float ltot = lsum + __shfl_xor(lsum, 32);
  const float inv = 1.0f / ltot;
  bf16_t* op = Op + (size_t)qrow * ldo + 4 * hi;
#pragma unroll
  for (int db = 0; db < NDB; ++db)
#pragma unroll
    for (int g = 0; g < 4; ++g) {
      f32x4 v = {o[db][4 * g + 0] * inv, o[db][4 * g + 1] * inv, o[db][4 * g + 2] * inv, o[db][4 * g + 3] * inv};
      st_bf4(op + 32 * db + 8 * g, v);
    }
}

typedef f32x4 pgacc_t[2][2][4][2];

DEV void st_bf8(bf16_t* p, f32x4 a, f32x4 b) { u32x4 w; w[0] = pk2(a[0], a[1]); w[1] = pk2(a[2], a[3]); w[2] = pk2(b[0], b[1]); w[3] = pk2(b[2], b[3]); *(u32x4*)p = w; }

struct EpiStoreBf16 {
  static constexpr bool PERM = true, AFTER_DRAIN = false;
  bf16_t* O; int ldc; int relu2;
  DEV void operator()(const pgacc_t& acc, const pg8::Unit& u, int wr, int wc, int fr, int fq) const {
    const int row0 = u.pm * 256 + wr * 64 + fr, col0 = u.pn * 256 + wc * 32 + 8 * fq;
#pragma unroll
    for (int ai = 0; ai < 2; ++ai)
#pragma unroll
      for (int m = 0; m < 4; ++m) {
        bf16_t* rp = O + (size_t)(row0 + ai * 128 + m * 16) * ldc + col0;
#pragma unroll
        for (int bj = 0; bj < 2; ++bj) {
          f32x4 v0 = acc[ai][bj][m][0], v1 = acc[ai][bj][m][1];
          if (relu2) {
#pragma unroll
            for (int e = 0; e < 4; ++e) { const float r0 = fmaxf(v0[e], 0.f), r1 = fmaxf(v1[e], 0.f); v0[e] = r0 * r0; v1[e] = r1 * r1; } }
          st_bf8(rp + bj * 128, v0, v1);
        }
      }
  }
};

struct EpiP1 {
  static constexpr bool PERM = true, AFTER_DRAIN = false;
  char* reg; const float* cst; const float* snt; const float* bforget; int tok0;
  DEV void operator()(const pgacc_t& acc, const pg8::Unit& u, int wr, int wc, int fr, int fq) const {
    const int r0 = u.pm * 256 + wr * 64 + fr, c0 = wc * 32 + fq * 8;
#pragma unroll
    for (int bj = 0; bj < 2; ++bj) {
      const int ct = 2 * u.pn + bj;
      if (ct < 45) {
        bf16_t* dst; int ld, cb; bool sg = false;
        if (ct < 12) { dst = (bf16_t*)(reg + R_FOX); ld = 1536; cb = ct * 128; }
        else if (ct < 15) { dst = (bf16_t*)(reg + R_CQ); ld = 384; cb = (ct - 12) * 128; }
        else if (ct < 17) { dst = (bf16_t*)(reg + R_CKV); ld = 256; cb = (ct - 15) * 128; }
        else if (ct < 21) { dst = (bf16_t*)(reg + R_QMEM); ld = 512; cb = (ct - 17) * 128; }
        else { dst = (bf16_t*)(reg + R_GATES); ld = 3072; cb = (ct - 21) * 128; sg = true; }
#pragma unroll
        for (int ai = 0; ai < 2; ++ai)
#pragma unroll
          for (int m = 0; m < 4; ++m) {
            f32x4 v0 = acc[ai][bj][m][0], v1 = acc[ai][bj][m][1];
            if (sg) {
#pragma unroll
              for (int e = 0; e < 4; ++e) { v0[e] = sigmoidf_(v0[e]); v1[e] = sigmoidf_(v1[e]); } }
            st_bf8(dst + (size_t)(r0 + ai * 128 + m * 16) * ld + cb + c0, v0, v1);
          }
      } else {
        bf16_t* kpe = (bf16_t*)(reg + R_KPE); float* logf_ = (float*)(reg + R_LOGF);
        if (wc == 0) {
          const int ci = 8 * (fq & 1);
#pragma unroll
          for (int ai = 0; ai < 2; ++ai)
#pragma unroll
            for (int m = 0; m < 4; ++m) {
              const int row = r0 + ai * 128 + m * 16; const size_t tok = (size_t)tok0 + row;
              f32x4 own[2], oth[2], o[2];
#pragma unroll
              for (int n = 0; n < 2; ++n) { own[n] = acc[ai][bj][m][n];
#pragma unroll
                for (int e = 0; e < 4; ++e) oth[n][e] = __shfl_xor(own[n][e], 32); }
#pragma unroll
              for (int n = 0; n < 2; ++n) {
                const f32x4 c = *(const f32x4*)(cst + tok * 16 + ci + 4 * n), s = *(const f32x4*)(snt + tok * 16 + ci + 4 * n);
                o[n] = (fq < 2) ? (own[n] * c - oth[n] * s) : (own[n] * c + oth[n] * s);
              }
              st_bf8(kpe + (size_t)row * 32 + (fq < 2 ? 0 : 16) + ci, o[0], o[1]);
            }
        } else if (wc == 2 && fq == 0) {
          const f32x4 bf0 = *(const f32x4*)(bforget), bf1 = *(const f32x4*)(bforget + 4);
#pragma unroll
          for (int ai = 0; ai < 2; ++ai)
#pragma unroll
            for (int m = 0; m < 4; ++m) {
              const int row = r0 + ai * 128 + m * 16; f32x4 v0 = acc[ai][bj][m][0] + bf0, v1 = acc[ai][bj][m][1] + bf1;
#pragma unroll
              for (int e = 0; e < 4; ++e) { v0[e] = log_sigmoidf_(v0[e]); v1[e] = log_sigmoidf_(v1[e]); }
              *(f32x4*)(logf_ + (size_t)row * 8) = v0; *(f32x4*)(logf_ + (size_t)row * 8 + 4) = v1;
            }
        }
      }
    }
  }
};

struct EpiResLn {
  static constexpr bool PERM = false, AFTER_DRAIN = false;
  float* h; bf16_t* hb; float* xbuf; unsigned* cnt; const float* lg; const float* lb; int grow_off; char* xl; int dry; int wf32;
  DEV void operator()(pgacc_t& acc, const pg8::Unit& u, int wr, int wc, int fr, int fq) const {
    const int tid = get_tid();
    const int grow0 = grow_off + u.pm * 256;
    const int col0 = u.pn * 256 + wc * 32 + 4 * fq;
    f32x2_t* P = (f32x2_t*)xl;
    f32x2_t* S = (f32x2_t*)(xl + 8192);
#pragma unroll
    for (int ai = 0; ai < 2; ++ai)
#pragma unroll
      for (int m = 0; m < 4; ++m) {
        const int rl = ai * 128 + wr * 64 + m * 16 + fr;
        const bf16_t* rp = hb + (size_t)(grow0 + rl) * D + col0;
        float s1 = 0.f, s2 = 0.f;
#pragma unroll
        for (int bj = 0; bj < 2; ++bj)
#pragma unroll
          for (int n = 0; n < 2; ++n) {
            const uint2 hw = *(const uint2*)(rp + bj * 128 + n * 16);
            const f32x4 z = (f32x4){bf_lo(hw.x), bf_hi(hw.x), bf_lo(hw.y), bf_hi(hw.y)} * ALPHA + acc[ai][bj][m][n];
            acc[ai][bj][m][n] = z;
            s1 += (z[0] + z[1]) + (z[2] + z[3]); s2 += (z[0] * z[0] + z[1] * z[1]) + (z[2] * z[2] + z[3] * z[3]);
          }
        s1 += __shfl_xor(s1, 16); s1 += __shfl_xor(s1, 32); s2 += __shfl_xor(s2, 16); s2 += __shfl_xor(s2, 32);
        if (fq == 0) P[rl * 4 + wc] = (f32x2_t){s1, s2};
      }
    __syncthreads();
    if (tid < 256) {
      const f32x2_t a = P[tid * 4 + 0], b = P[tid * 4 + 1], c = P[tid * 4 + 2], d = P[tid * 4 + 3];
      *(f32x2_t*)(xbuf + ((size_t)(grow0 + tid) * 4 + u.pn) * 2) = (f32x2_t){(a[0] + b[0]) + (c[0] + d[0]), (a[1] + b[1]) + (c[1] + d[1])};
    }
    asm volatile("s_waitcnt vmcnt(0)" ::: "memory");
    __syncthreads();
    if (tid == 0) {
      __builtin_amdgcn_fence(__ATOMIC_RELEASE, "agent");
      asm volatile("s_waitcnt vmcnt(0)" ::: "memory");
      unsigned* c = cnt + (grow0 >> 8);
      __hip_atomic_fetch_add(c, 1u, __ATOMIC_RELAXED, __HIP_MEMORY_SCOPE_AGENT);
      while (__hip_atomic_load(c, __ATOMIC_RELAXED, __HIP_MEMORY_SCOPE_AGENT) < 4u) __builtin_amdgcn_s_sleep(1);
      __builtin_amdgcn_fence(__ATOMIC_ACQUIRE, "agent");
      asm volatile("s_waitcnt vmcnt(0)" ::: "memory");
    }
    __syncthreads();
    if (tid < 256) {
      const f32x4 t0 = *(const f32x4*)(xbuf + (size_t)(grow0 + tid) * 8), t1 = *(const f32x4*)(xbuf + (size_t)(grow0 + tid) * 8 + 4);
      const float mean = ((t0[0] + t0[2]) + (t1[0] + t1[2])) * (1.0f / 1024.0f);
      const float var = fmaxf(((t0[1] + t0[3]) + (t1[1] + t1[3])) * (1.0f / 1024.0f) - mean * mean, 0.f);
      S[tid] = (f32x2_t){mean, rsqrtf(var + 1e-5f)};
    }
    __syncthreads();
#pragma unroll
    for (int bj = 0; bj < 2; ++bj)
#pragma unroll
      for (int n = 0; n < 2; ++n) {
        const f32x4 gv = *(const f32x4*)(lg + col0 + bj * 128 + n * 16), bv = *(const f32x4*)(lb + col0 + bj * 128 + n * 16);
#pragma unroll
        for (int ai = 0; ai < 2; ++ai)
#pragma unroll
          for (int m = 0; m < 4; ++m) {
            const int rl = ai * 128 + wr * 64 + m * 16 + fr;
            const f32x2_t st = S[rl];
            const size_t off = (size_t)(grow0 + rl) * D + col0 + bj * 128 + n * 16;
            const f32x4 y = (acc[ai][bj][m][n] - st[0]) * st[1] * gv + bv;
            if (!dry) { if (wf32) *(f32x4*)(h + off) = y; st_bf4(hb + off, y); }
            else if (y[0] == 1.2345e30f) *(f32x4*)(h + off) = y;
          }
      }
    __syncthreads();
  }
};

struct EpiNull {
  static constexpr bool PERM = false, AFTER_DRAIN = false;
  float* sink;
  DEV void operator()(const pgacc_t& acc, const pg8::Unit& u, int wr, int wc, int fr, int fq) const {
    float t = 0.f;
#pragma unroll
    for (int ai = 0; ai < 2; ++ai)
#pragma unroll
      for (int bj = 0; bj < 2; ++bj)
#pragma unroll
        for (int m = 0; m < 4; ++m)
#pragma unroll
          for (int n = 0; n < 2; ++n) t += acc[ai][bj][m][n][0] + acc[ai][bj][m][n][1] + acc[ai][bj][m][n][2] + acc[ai][bj][m][n][3];
    if (t == 1.2345e30f) *sink = t;
  }
};

template <class Epi>
DEV void pg_gemm(char* lds, const bf16_t* A, const bf16_t* Bt, int M, int N, int K, int G, int c, const Epi& E) {
  pg8::Gemm g; g.A = A; g.Bt = Bt; g.M = M; g.N = N; g.K = K;
  pg8::StaticOrder S; S.init(M, N, G, c);
  pg8::gemm_phase<Epi, pg8::StaticOrder, true, true>((PG8_LAS unsigned char*)lds, g, S, E);
}

DEV void step_prep(const Params& p, char* lds) {
  const int bx_ = get_bx(), gx_ = get_gx();
  const int t512 = get_tid(), tid = t512 & 255, grp = t512 >> 8;
  bf16_t* wt = (bf16_t*)(p.ws + OFF_WT);
  constexpr int TPL = 4552;
  const int vgrid = gx_ * 2, vb = bx_ * 2 + grp;
  for (int base = 0; base < TPL * DEPTH; base += vgrid) {
    const int t = base + vb; const bool valid = t < TPL * DEPTH; const int tt = valid ? t : 0;
    const int l = tt / TPL; int r = tt % TPL;
    bf16_t* wl = wt + (size_t)l * WL;
    const float* src; int ldsrc, K; bf16_t* dst; bool wm = false; const float* ks = nullptr;
    if (r < 1472) { src = p.w_in + (size_t)l * 1024 * 5800; ldsrc = 5800; K = 1024; dst = wl + WO_IN; wm = true; }
    else if (r < 1544) { r -= 1472; src = p.w_uq + (size_t)l * 384 * 768; ldsrc = 768; K = 384; dst = wl + WO_UQ; ks = p.g_cq + l * 384; }
    else if (r < 1608) { r -= 1544; src = p.w_ukv + (size_t)l * 256 * 1024; ldsrc = 1024; K = 256; dst = wl + WO_UKV; ks = p.g_ckv + l * 256; }
    else if (r < 1864) { r -= 1608; src = p.w_mem_kv + (size_t)l * 1024 * 1024; ldsrc = 1024; K = 1024; dst = wl + WO_MKV; }
    else if (r < 2248) { r -= 1864; const int n = r / 128; r %= 128; src = p.w_br + ((size_t)l * 3 + n) * 512 * 1024; ldsrc = 1024; K = 512; dst = wl + WO_BR + (size_t)n * 1024 * 512; }
    else if (r < 2504) { r -= 2248; src = p.w_out + (size_t)l * 1024 * 1024; ldsrc = 1024; K = 1024; dst = wl + WO_OUT; }
    else if (r < 3528) { r -= 2504; src = p.w_ff1 + (size_t)l * 1024 * 4096; ldsrc = 4096; K = 1024; dst = wl + WO_FF1; }
    else { r -= 3528; src = p.w_ff2 + (size_t)l * 4096 * 1024; ldsrc = 1024; K = 4096; dst = wl + WO_FF2; }
    const int nkt = K >> 6; const int kt = r % nkt, ntile = r / nkt;
    transpose_tile(tid, valid, src, ldsrc, K, dst, ntile * 64, kt * 64, wm, ks, lds + grp * GRP_LDS);
  }
  {
    const int lane = t512 & 63, gw = bx_ * 8 + (t512 >> 6), nw = gx_ * 8;
    bf16_t* hb = (bf16_t*)(p.ws + OFF_HB);
    f32x4 gv[4], bv[4];
#pragma unroll
    for (int i = 0; i < 4; ++i) { gv[i] = *(const f32x4*)(p.ln_in_g + lane * 4 + 256 * i); bv[i] = *(const f32x4*)(p.ln_in_b + lane * 4 + 256 * i); }
    for (int row = gw; row < NTOK; row += nw) {
      const float* xp = p.x + (size_t)row * D + lane * 4;
      f32x4 v[4];
#pragma unroll
      for (int i = 0; i < 4; ++i) v[i] = *(const f32x4*)(xp + 256 * i);
      float s = 0.f;
#pragma unroll
      for (int i = 0; i < 4; ++i) s += (v[i][0] + v[i][1]) + (v[i][2] + v[i][3]);
      const float mean = wave_sum(s) * (1.0f / 1024.0f);
      float q = 0.f;
#pragma unroll
      for (int i = 0; i < 4; ++i) { v[i] = v[i] - mean; q += (v[i][0] * v[i][0] + v[i][1] * v[i][1]) + (v[i][2] * v[i][2] + v[i][3] * v[i][3]); }
      const float rstd = rsqrtf(wave_sum(q) * (1.0f / 1024.0f) + 1e-5f);
      bf16_t* bp = hb + (size_t)row * D + lane * 4;
#pragma unroll
      for (int i = 0; i < 4; ++i) { const f32x4 y = v[i] * rstd * gv[i] + bv[i]; st_bf4(bp + 256 * i, y); }
    }
  }
  {
    bf16_t* mb = (bf16_t*)(p.ws + OFF_REG);
    for (int i = bx_ * 512 + t512; i < 4096 * 1024 / 4; i += gx_ * 512) { const f32x4 v = *(const f32x4*)(p.mem + (size_t)i * 4); st_bf4(mb + (size_t)i * 4, v); }
  }
  {
    float* ct = (float*)(p.ws + OFF_ROPE); float* st = ct + (size_t)NTOK * 16;
    for (int i = bx_ * 512 + t512; i < NTOK * 16; i += gx_ * 512) {
      const int tok = i >> 4, f = i & 15;
      const float inv_freq = powf(10000.0f, -(float)(2 * f) / 32.0f);
      const float ang = (float)p.pos[tok] * inv_freq;
      float s, c; sincosf(ang, &s, &c);
      ct[i] = c; st[i] = s;
    }
  }
}

DEV void step_mkv(const Params& p, char* lds) {
  const int bx_ = get_bx(), gx_ = get_gx();
  const bf16_t* mb = (const bf16_t*)(p.ws + OFF_REG);
  for (int l = bx_ >> 6; l < DEPTH; l += (gx_ >> 6)) {
    const bf16_t* wt = (const bf16_t*)(p.ws + OFF_WT) + (size_t)l * WL + WO_MKV;
    EpiStoreBf16 E; E.O = (bf16_t*)(p.ws + OFF_MKV) + (size_t)l * 4096 * 1024; E.ldc = 1024; E.relu2 = 0;
    pg_gemm(lds, mb, wt, 4096, 1024, 1024, 64, bx_ & 63, E);
  }
}

DEV void step_p1(const Params& p, int l, int g, char* lds) {
  const int bx_ = get_bx(), gx_ = get_gx();
  EpiP1 E; E.reg = p.ws + OFF_REG; E.cst = (const float*)(p.ws + OFF_ROPE); E.snt = E.cst + (size_t)NTOK * 16; E.bforget = p.b_forget + l * 8; E.tok0 = g * HTOK;
  pg_gemm(lds, (const bf16_t*)(p.ws + OFF_HB) + (size_t)g * HTOK * D, (const bf16_t*)(p.ws + OFF_WT) + (size_t)l * WL + WO_IN, HTOK, DINP, D, gx_, bx_, E);
}

DEV void step_p2(const Params& p, int l, int g, char* lds512) {
  const int bx_ = get_bx(), gx_ = get_gx();
  const int t512 = get_tid(), tid = t512 & 255, grp = t512 >> 8;
  const int lane = tid & 63, wid = tid >> 6, wm = wid >> 1, wn = wid & 1, fr = lane & 15, fq = lane >> 4;
  char* lds = lds512 + grp * GRP_LDS;
  const int vgrid = gx_ * 2, vb = bx_ * 2 + grp;
  char* reg = p.ws + OFF_REG;
  const bf16_t* wl = (const bf16_t*)(p.ws + OFF_WT) + (size_t)l * WL;
  const float* cst = (const float*)(p.ws + OFF_ROPE); const float* snt = cst + (size_t)NTOK * 16;
  float* rowss = (float*)(lds + 65536);
  {
    const bf16_t* cq = (const bf16_t*)(reg + R_CQ); bf16_t* qbuf = (bf16_t*)(reg + R_QB);
    const int nit = gemm_iters(vgrid, 128, 6);
    for (int it = 0; it < nit; ++it) {
      int rb, ct; const bool valid = gemm_sched(vb, vgrid, it, 128, 6, rb, ct); if (!valid) { rb = 0; ct = 0; }
      f32x4 acc[4][4]; zero_acc(acc);
      gemm_main<true>(tid, cq + (size_t)rb * 128 * 384, 384, wl + WO_UQ + (size_t)ct * 128 * 384, 384, 384, lds, acc, rowss);
      if (valid) {
#pragma unroll
        for (int m = 0; m < 4; ++m) {
          const int rl = wm * 64 + m * 16 + fr, row = rb * 128 + rl; const size_t tok = (size_t)g * HTOK + row;
          const float rs = rsqrtf(rowss[rl] * (1.0f / 384.0f) + 1e-6f);
#pragma unroll
          for (int n = 0; n < 4; ++n) acc[m][n] = acc[m][n] * rs;
#pragma unroll
          for (int n = 0; n < 4; n += 2) {
            const int cn = ct * 128 + wn * 64 + n * 16;
            if (cn % 96 == 64) {
              const f32x4 c = *(const f32x4*)(cst + tok * 16 + fq * 4), s = *(const f32x4*)(snt + tok * 16 + fq * 4);
              const f32x4 x1 = acc[m][n], x2 = acc[m][n + 1];
              acc[m][n] = x1 * c - x2 * s; acc[m][n + 1] = x2 * c + x1 * s;
            }
          }
#pragma unroll
          for (int n = 0; n < 4; ++n) st_bf4(qbuf + (size_t)row * 768 + ct * 128 + wn * 64 + n * 16 + fq * 4, acc[m][n]);
        }
      }
      __syncthreads();
    }
  }
  {
    const bf16_t* ckv = (const bf16_t*)(reg + R_CKV); bf16_t* kvb = (bf16_t*)(reg + R_KVB);
    const int nit = gemm_iters(vgrid, 128, 8);
    for (int it = 0; it < nit; ++it) {
      int rb, ct; const bool valid = gemm_sched(vb, vgrid, it, 128, 8, rb, ct); if (!valid) { rb = 0; ct = 0; }
      f32x4 acc[4][4]; zero_acc(acc);
      gemm_main<true>(tid, ckv + (size_t)rb * 128 * 256, 256, wl + WO_UKV + (size_t)ct * 128 * 256, 256, 256, lds, acc, rowss);
      if (valid) {
#pragma unroll
        for (int m = 0; m < 4; ++m) {
          const int rl = wm * 64 + m * 16 + fr, row = rb * 128 + rl;
          const float rs = rsqrtf(rowss[rl] * (1.0f / 256.0f) + 1e-6f);
#pragma unroll
          for (int n = 0; n < 4; ++n) st_bf4(kvb + (size_t)row * 1024 + ct * 128 + wn * 64 + n * 16 + fq * 4, acc[m][n] * rs);
        }
      }
      __syncthreads();
    }
  }
  for (int b = bx_; b < 8; b += gx_) {
    const float* lf = (const float*)(reg + R_LOGF) + (size_t)b * SEQ * 8; float* cf = (float*)(reg + R_CUMF) + (size_t)b * SEQ * 8;
    float* sl = (float*)lds512;
    const int h = t512 & 7, sgm = (t512 >> 3) & 31;
    float s = 0.f;
    if (t512 < 256) { for (int i = 0; i < 64; ++i) s += lf[(size_t)(sgm * 64 + i) * 8 + h]; sl[sgm * 8 + h] = s; }
    __syncthreads();
    if (t512 < 256) {
      float run = 0.f;
      for (int j = 0; j < sgm; ++j) run += sl[j * 8 + h];
      for (int i = 0; i < 64; ++i) { run += lf[(size_t)(sgm * 64 + i) * 8 + h]; cf[(size_t)(sgm * 64 + i) * 8 + h] = run; }
    }
    __syncthreads();
  }
}

DEV void step_p3(const Params& p, int l, int g, char* lds512, int dup = 0) {
  const int bx_ = get_bx(), gx_ = get_gx();
  const int t512 = get_tid(), tid = t512 & 255, grp = t512 >> 8;
  char* lds = lds512 + grp * GRP_LDS;
  char* reg = p.ws + OFF_REG;
  unsigned* qctr = (unsigned*)(p.ws + OFF_CTRL) + CT_QUEUE + l * 2 + g + dup * 8;
  int* sflag = (int*)(lds512 + SMEM_BYTES - 16);
  bf16_t* fox = (bf16_t*)(reg + R_FOX); const bf16_t* qmem = (const bf16_t*)(reg + R_QMEM); bf16_t* oc = (bf16_t*)(reg + R_CQ);
  const bf16_t* qbuf = (const bf16_t*)(reg + R_QB);
  const bf16_t* kvb = (const bf16_t*)(reg + R_KVB); const bf16_t* kpe = (const bf16_t*)(reg + R_KPE); bf16_t* ob = (bf16_t*)(reg + R_OB);
  const float* cumf = (const float*)(reg + R_CUMF);
  const bf16_t* mkv = (const bf16_t*)(p.ws + OFF_MKV) + (size_t)l * 4096 * 1024;
  for (;;) {
    if (threadIdx.x == 0) *sflag = (int)__hip_atomic_fetch_add(qctr, 1u, __ATOMIC_RELAXED, __HIP_MEMORY_SCOPE_AGENT);
    __syncthreads();
    const int u2 = *sflag;
    __syncthreads();
    if (u2 >= 1536) break;
    const int u = 2 * u2 + grp;
    if (u < 2048) {
      const int qb = 15 - (u >> 7), rem = u & 127, mode = rem >> 6, bh = rem & 63, b = bh >> 3, h = bh & 7;
      if (mode == 0) {
        bf16_t* qs = fox + (size_t)b * SEQ * 1536 + h * 64;
        int t0_ = tid; asm volatile("" : "+v"(t0_));
        attn_unit<64, 64, 0>(t0_, qs, 1536, qs + 512, 1536, nullptr, qs + 1024, 1536, dup ? ob + (size_t)b * SEQ * 512 + h * 64 : qs, dup ? 512 : 1536, cumf + (size_t)b * SEQ * 8 + h, qb, 0.125f * LOG2E, lds);
      } else {
        const bf16_t* qs = qbuf + (size_t)b * SEQ * 768 + h * 96; const bf16_t* ks = kvb + (size_t)b * SEQ * 1024 + h * 128;
        int t1_ = tid; asm volatile("" : "+v"(t1_));
        attn_unit<96, 64, 1>(t1_, qs, 768, ks, 1024, kpe + (size_t)b * SEQ * 32, ks + 64, 1024, ob + (size_t)b * SEQ * 512 + h * 64, 512, nullptr, qb, 0.10206207261596575f * LOG2E, lds);
      }
    } else {
      const int v = u - 2048, qb = v & 15, dh = (v >> 4) & 1, bh = v >> 5, b = bh >> 2, h = bh & 3;
      const bf16_t* qs = qmem + (size_t)b * SEQ * 512 + h * 128; const bf16_t* ks = mkv + (size_t)(g * 8 + b) * NMEM * 1024 + h * 128;
      int t2_ = tid; asm volatile("" : "+v"(t2_));
      attn_unit<128, 64, 2>(t2_, qs, 512, ks, 1024, nullptr, ks + 512 + dh * 64, 1024, oc + (size_t)b * SEQ * 512 + h * 128 + dh * 64, 512, nullptr, qb, 0.08838834764831845f * LOG2E, lds);
    }
  }
}

DEV void step_p4(const Params& p, int l, int g, char* lds512) {
  const int bx_ = get_bx(), gx_ = get_gx();
  const int t512 = get_tid(), tid = t512 & 255, grp = t512 >> 8;
  const int lane = tid & 63, wid = tid >> 6, wm = wid >> 1, wn = wid & 1, fr = lane & 15, fq = lane >> 4;
  char* lds = lds512 + grp * GRP_LDS;
  const int vgrid = gx_ * 2, vb = bx_ * 2 + grp;
  char* reg = p.ws + OFF_REG;
  const bf16_t* wbr = (const bf16_t*)(p.ws + OFF_WT) + (size_t)l * WL + WO_BR;
  const bf16_t* gates = (const bf16_t*)(reg + R_GATES); bf16_t* merged = (bf16_t*)(reg + R_KVB);
  const int nit = gemm_iters(vgrid, 128, 8);
  for (int it = 0; it < nit; ++it) {
    int rb, ct; const bool valid = gemm_sched(vb, vgrid, it, 128, 8, rb, ct); if (!valid) { rb = 0; ct = 0; }
    f32x4 macc[4][4]; zero_acc(macc);
#pragma unroll 1
    for (int n3 = 0; n3 < 3; ++n3) {
      const bf16_t* A; int lda;
      if (n3 == 0) { A = (const bf16_t*)(reg + R_FOX); lda = 1536; } else if (n3 == 1) { A = (const bf16_t*)(reg + R_OB); lda = 512; } else { A = (const bf16_t*)(reg + R_CQ); lda = 512; }
      f32x4 acc[4][4]; zero_acc(acc);
      gemm_glds(tid, A + (size_t)rb * 128 * lda, lda, wbr + (size_t)n3 * 1024 * 512 + (size_t)ct * 128 * 512, 512, 512, lds, acc);
#pragma unroll
      for (int m = 0; m < 4; ++m)
#pragma unroll
        for (int n = 0; n < 4; ++n) {
          const uint2 gw = *(const uint2*)(gates + (size_t)(rb * 128 + wm * 64 + m * 16 + fr) * 3072 + n3 * 1024 + ct * 128 + wn * 64 + n * 16 + fq * 4);
          const f32x4 gv = {bf_lo(gw.x), bf_hi(gw.x), bf_lo(gw.y), bf_hi(gw.y)};
          macc[m][n] += gv * acc[m][n];
        }
    }
    if (valid) {
#pragma unroll
      for (int m = 0; m < 4; ++m)
#pragma unroll
        for (int n = 0; n < 4; ++n) st_bf4(merged + (size_t)(rb * 128 + wm * 64 + m * 16 + fr) * 1024 + ct * 128 + wn * 64 + n * 16 + fq * 4, macc[m][n]);
    }
  }
}

DEV void run_step(const Params& p, int s, char* lds) {
  const int bx_ = get_bx(), gx_ = get_gx();
  if (s == 0) { int reps = 1 + ((PROBE_DUP >> 6) & 1); asm volatile("" : "+s"(reps));
#pragma unroll 1
    for (int rep = 0; rep < reps; ++rep) step_prep(p, lds);
    return; }
  if (s == 1) { step_mkv(p, lds); return; }
  const int ls = s - 2, l = ls / 11, r = ls % 11;
  unsigned* ctrl = (unsigned*)(p.ws + OFF_CTRL);
  const bf16_t* wl = (const bf16_t*)(p.ws + OFF_WT) + (size_t)l * WL;
  if (r < 9) {
    const int g = (r >= 5) ? 1 : 0, ph = (r >= 5) ? r - 4 : r;
    if (ph == 0) { step_p1(p, l, g, lds); if (PROBE_DUP & 1) step_p1(p, l, g, lds); }
    else if (ph == 1) { step_p2(p, l, g, lds); if (PROBE_DUP & 2) step_p2(p, l, g, lds); }
    else if (ph == 2) { if (PROBE_DUP & 4) step_p3(p, l, g, lds, 1); step_p3(p, l, g, lds); }
    else if (ph == 3) { step_p4(p, l, g, lds); if (PROBE_DUP & 8) step_p4(p, l, g, lds); }
    else {
      EpiResLn E; E.h = p.out; E.hb = (bf16_t*)(p.ws + OFF_HB); E.cnt = ctrl + CT_LN + (l * 2 + 0) * 256; E.lg = p.ln1_g + l * D; E.lb = p.ln1_b + l * D; E.grow_off = g * HTOK; E.xbuf = (float*)(p.ws + OFF_XBUF); E.xl = lds + XL_OFF; E.dry = 0; E.wf32 = 0;
      if (PROBE_DUP & 512) { EpiResLn E2 = E; E2.dry = 1; E2.cnt = E.cnt + 2048; E2.xbuf = E.xbuf + (size_t)NTOK * 8; pg_gemm(lds, (const bf16_t*)(p.ws + OFF_REG + R_KVB), wl + WO_OUT, HTOK, D, D, gx_, bx_, E2); }
      if (PROBE_DUP & 128) { EpiNull N; N.sink = (float*)(p.ws + OFF_CTRL + 32768); pg_gemm(lds, (const bf16_t*)(p.ws + OFF_REG + R_KVB), wl + WO_OUT, HTOK, D, D, gx_, bx_, N); }
      pg_gemm(lds, (const bf16_t*)(p.ws + OFF_REG + R_KVB), wl + WO_OUT, HTOK, D, D, gx_, bx_, E);
      if (g == 0) { step_p1(p, l, 1, lds); if (PROBE_DUP & 1) step_p1(p, l, 1, lds); }
    }
  } else if (r == 9) {
    EpiStoreBf16 E; E.O = (bf16_t*)(p.ws + OFF_REG); E.ldc = DFF; E.relu2 = 1;
    pg_gemm(lds, (const bf16_t*)(p.ws + OFF_HB), wl + WO_FF1, NTOK, DFF, D, gx_, bx_, E);
    if (PROBE_DUP & 16) pg_gemm(lds, (const bf16_t*)(p.ws + OFF_HB), wl + WO_FF1, NTOK, DFF, D, gx_, bx_, E);
  } else {
    EpiResLn E; E.h = p.out; E.hb = (bf16_t*)(p.ws + OFF_HB); E.cnt = ctrl + CT_LN + (l * 2 + 1) * 256; E.lg = p.ln2_g + l * D; E.lb = p.ln2_b + l * D; E.grow_off = 0; E.xbuf = (float*)(p.ws + OFF_XBUF); E.xl = lds + XL_OFF; E.dry = 0; E.wf32 = (l == DEPTH - 1) ? 1 : 0;
    if (PROBE_DUP & 1024) { EpiResLn E2 = E; E2.dry = 1; E2.cnt = E.cnt + 2048; E2.xbuf = E.xbuf + (size_t)NTOK * 8; pg_gemm(lds, (const bf16_t*)(p.ws + OFF_REG), wl + WO_FF2, NTOK, D, DFF, gx_, bx_, E2); }
    if (PROBE_DUP & 256) { EpiNull N; N.sink = (float*)(p.ws + OFF_CTRL + 32768); pg_gemm(lds, (const bf16_t*)(p.ws + OFF_REG), wl + WO_FF2, NTOK, D, DFF, gx_, bx_, N); }
    pg_gemm(lds, (const bf16_t*)(p.ws + OFF_REG), wl + WO_FF2, NTOK, D, DFF, gx_, bx_, E);
  }
}

__global__ void __launch_bounds__(512, 2) mega(Params p, int s_begin, int s_end) {
  __shared__ __attribute__((aligned(16))) char smem[SMEM_BYTES];
  for (int s = s_begin; s < s_end; ++s) {
    typedef const __attribute__((address_space(4))) Params* KP;
    KP kp = (KP)__builtin_amdgcn_kernarg_segment_ptr();
    asm volatile("" : "+s"(kp));
    Params q;
    q.x = kp->x; q.mem = kp->mem; q.pos = kp->pos; q.ln_in_g = kp->ln_in_g; q.ln_in_b = kp->ln_in_b; q.w_in = kp->w_in; q.b_forget = kp->b_forget;
    q.w_uq = kp->w_uq; q.g_cq = kp->g_cq; q.w_ukv = kp->w_ukv; q.g_ckv = kp->g_ckv; q.w_mem_kv = kp->w_mem_kv; q.w_br = kp->w_br; q.w_out = kp->w_out;
    q.ln1_g = kp->ln1_g; q.ln1_b = kp->ln1_b; q.w_ff1 = kp->w_ff1; q.w_ff2 = kp->w_ff2; q.ln2_g = kp->ln2_g; q.ln2_b = kp->ln2_b; q.out = kp->out; q.ws = kp->ws;
    run_step(q, s, smem);
    if (s + 1 < s_end) {
      if (s == 0) cg::this_grid().sync();
      else grid_barrier((unsigned*)(q.ws + OFF_CTRL) + CT_BAR, (unsigned)s);
    }
  }
}

extern "C" void kernel_launch(void* const* d_in, const int* in_sizes, int n_in, void* d_out, int out_size, void* d_ws, size_t ws_size, hipStream_t stream) {
  static int grid_blocks = 0;
  if (!grid_blocks) {
    int dev = 0, cus = 0, per_cu = 0;
    (void)hipGetDevice(&dev);
    (void)hipDeviceGetAttribute(&cus, hipDeviceAttributeMultiprocessorCount, dev);
    (void)hipOccupancyMaxActiveBlocksPerMultiprocessor(&per_cu, mega, 512, 0);
    if (per_cu < 1) fprintf(stderr, "occupancy query returned %d\n", per_cu);
    grid_blocks = (cus / 64) * 64;
  }
  if (ws_size < WS_NEED) { fprintf(stderr, "workspace too small: %zu < %zu\n", ws_size, (size_t)WS_NEED); return; }
  Params p{};
  p.x = (const float*)d_in[0]; p.mem = (const float*)d_in[1]; p.pos = (const int*)d_in[2];
  p.ln_in_g = (const float*)d_in[3]; p.ln_in_b = (const float*)d_in[4]; p.w_in = (const float*)d_in[5]; p.b_forget = (const float*)d_in[6];
  p.w_uq = (const float*)d_in[7]; p.g_cq = (const float*)d_in[8]; p.w_ukv = (const float*)d_in[9]; p.g_ckv = (const float*)d_in[10];
  p.w_mem_kv = (const float*)d_in[11]; p.w_br = (const float*)d_in[12]; p.w_out = (const float*)d_in[13]; p.ln1_g = (const float*)d_in[14]; p.ln1_b = (const float*)d_in[15];
  p.w_ff1 = (const float*)d_in[16]; p.w_ff2 = (const float*)d_in[17]; p.ln2_g = (const float*)d_in[18]; p.ln2_b = (const float*)d_in[19];
  p.out = (float*)d_out; p.ws = (char*)d_ws;
  (void)hipMemsetAsync(d_ws, 0, CTRL_BYTES, stream);
#if MULTI_LAUNCH
  for (int s = 0; s < NSTEPS; ++s) hipLaunchKernelGGL(mega, dim3(grid_blocks), dim3(512), 0, stream, p, s, s + 1);
#else
  int sb = 0, se = NSTEPS;
  void* args[] = {&p, &sb, &se};
  hipError_t e = hipLaunchCooperativeKernel((void*)mega, dim3(grid_blocks), dim3(512), args, 0, stream);
  if (e != hipSuccess) fprintf(stderr, "cooperative launch failed: %s (grid %d)\n", hipGetErrorString(e), grid_blocks);
#endif
}
```

```cpp
#include <hip/hip_runtime.h>
#include <hip/hip_cooperative_groups.h>
#include <cstdio>
#include <cstdint>
namespace cg = cooperative_groups;

#ifndef PROBE_DUP
#define PROBE_DUP 0
#endif
#ifndef MULTI_LAUNCH
#define MULTI_LAUNCH 0
#endif

typedef unsigned short bf16_t;
typedef short bf16x8 __attribute__((ext_vector_type(8)));
typedef short s16x4 __attribute__((ext_vector_type(4)));
typedef float f32x4 __attribute__((ext_vector_type(4)));
typedef float f32x16 __attribute__((ext_vector_type(16)));
typedef float f32x2_t __attribute__((ext_vector_type(2)));
typedef __bf16 bf16x2_t __attribute__((ext_vector_type(2)));
typedef __attribute__((address_space(3))) const char* lds_cptr;
typedef short v4i16_t __attribute__((ext_vector_type(4)));
typedef unsigned u32x4 __attribute__((ext_vector_type(4)));

#define DEV __device__ __forceinline__
#define LAS3 __attribute__((address_space(3)))
DEV int get_bx() { int t = blockIdx.x; asm volatile("" : "+s"(t)); return t; }
DEV int get_gx() { int t = gridDim.x; asm volatile("" : "+s"(t)); return t; }
DEV int get_tid() { int t = threadIdx.x; asm volatile("" : "+v"(t)); return t; }

constexpr int D = 1024, SEQ = 2048, NTOK = 32768, HTOK = 16384, DEPTH = 4, DINP = 5888, DFF = 4096, NMEM = 256;
constexpr float ALPHA = 1.6817928305074290f;
constexpr float LOG2E = 1.4426950408889634f;
constexpr float NEG = -1e30f;

constexpr size_t WO_IN = 0, WO_UQ = 6029312, WO_UKV = 6324224, WO_MKV = 6586368, WO_BR = 7634944, WO_OUT = 9207808,
                 WO_FF1 = 10256384, WO_FF2 = 14450688, WL = 18644992;
constexpr size_t OFF_CTRL = 0, CTRL_BYTES = 65536;
constexpr size_t OFF_WT = OFF_CTRL + CTRL_BYTES;
constexpr size_t OFF_HB = OFF_WT + WL * 2 * DEPTH;
constexpr size_t OFF_MKV = OFF_HB + (size_t)NTOK * D * 2;
constexpr size_t OFF_ROPE = OFF_MKV + (size_t)DEPTH * 4096 * 1024 * 2;
constexpr size_t OFF_REG = OFF_ROPE + (size_t)NTOK * 16 * 4 * 2;
constexpr size_t REG_BYTES = (size_t)NTOK * DFF * 2;
constexpr size_t OFF_XBUF = OFF_REG + REG_BYTES;
constexpr size_t WS_NEED = OFF_XBUF + (size_t)NTOK * 4 * 8 * 2;
constexpr size_t R_FOX = 0;
constexpr size_t R_CQ = R_FOX + (size_t)HTOK * 1536 * 2;
constexpr size_t R_CKV = R_CQ + (size_t)HTOK * 384 * 2;
constexpr size_t R_QMEM = R_CKV + (size_t)HTOK * 256 * 2;
constexpr size_t R_GATES = R_QMEM + (size_t)HTOK * 512 * 2;
constexpr size_t R_QB = R_GATES + (size_t)HTOK * 3072 * 2;
constexpr size_t R_KVB = R_QB + (size_t)HTOK * 768 * 2;
constexpr size_t R_OB = R_KVB + (size_t)HTOK * 1024 * 2;
constexpr size_t R_LOGF = R_OB + (size_t)HTOK * 512 * 2;
constexpr size_t R_CUMF = R_LOGF + (size_t)HTOK * 8 * 4;
constexpr size_t R_KPE = R_CUMF + (size_t)HTOK * 8 * 4;
constexpr size_t R_END = R_KPE + (size_t)HTOK * 32 * 2;
static_assert(R_END <= REG_BYTES, "region overflow");
constexpr int CT_BAR = 0, CT_QUEUE = 16, CT_LN = 64;

constexpr int GRP_LDS = 66048;
constexpr int XL_OFF = 131072;
constexpr int SMEM_BYTES = XL_OFF + 10240 + 1024;
constexpr int NSTEPS = 2 + DEPTH * 11;

struct Params {
  const float *x, *mem; const int* pos;
  const float *ln_in_g, *ln_in_b, *w_in, *b_forget, *w_uq, *g_cq, *w_ukv, *g_ckv, *w_mem_kv, *w_br, *w_out, *ln1_g, *ln1_b, *w_ff1, *w_ff2, *ln2_g, *ln2_b;
  float* out; char* ws;
};

DEV unsigned pk2(float lo, float hi) { f32x2_t v = {lo, hi}; bf16x2_t b = __builtin_convertvector(v, bf16x2_t); return __builtin_bit_cast(unsigned, b); }
DEV float bf_lo(unsigned u) { return __uint_as_float(u << 16); }
DEV float bf_hi(unsigned u) { return __uint_as_float(u & 0xffff0000u); }
DEV void st_bf4(bf16_t* p, f32x4 v) { uint2 w; w.x = pk2(v[0], v[1]); w.y = pk2(v[2], v[3]); *(uint2*)p = w; }
DEV float wave_sum(float v) {
  v += __shfl_xor(v, 32); v += __shfl_xor(v, 16); v += __shfl_xor(v, 8); v += __shfl_xor(v, 4); v += __shfl_xor(v, 2); v += __shfl_xor(v, 1); return v;
}
DEV float sigmoidf_(float x) { return 1.0f / (1.0f + __expf(-x)); }
DEV float log_sigmoidf_(float x) { return fminf(x, 0.f) - log1pf(expf(-fabsf(x))); }

DEV void grid_barrier(unsigned* ctr, unsigned nbar) {
  asm volatile("s_waitcnt vmcnt(0)" ::: "memory");
  __syncthreads();
  if (threadIdx.x == 0) {
    __builtin_amdgcn_fence(__ATOMIC_RELEASE, "agent");
    asm volatile("s_waitcnt vmcnt(0)" ::: "memory");
    __hip_atomic_fetch_add(ctr, 1u, __ATOMIC_RELAXED, __HIP_MEMORY_SCOPE_AGENT);
    const unsigned target = nbar * gridDim.x;
    while (__hip_atomic_load(ctr, __ATOMIC_RELAXED, __HIP_MEMORY_SCOPE_AGENT) < target) __builtin_amdgcn_s_sleep(4);
    __builtin_amdgcn_fence(__ATOMIC_ACQUIRE, "agent");
    asm volatile("s_waitcnt vmcnt(0)" ::: "memory");
  }
  __syncthreads();
}

namespace pg8 {
#define PG8_LAS __attribute__((address_space(3)))
typedef unsigned short bf16_t;
typedef short bf16x8 __attribute__((ext_vector_type(8)));
typedef float f32x4 __attribute__((ext_vector_type(4)));
typedef unsigned u32x4 __attribute__((ext_vector_type(4)));
constexpr int BM = 256, BK = 64, HALF = 128, HTB = HALF * BK * 2  , STAGE_BYTES = 8 * HTB, NXCD = 8, WGM = 8;

__host__ __device__ __forceinline__ int lds_byte(int r, int c) { const int st = (r >> 4) * 2 + (c >> 5), rr = r & 15, cc = c & 31, ob = rr * 64 + cc * 2; return st * 1024 + (ob ^ (((ob >> 9) & 1) << 5)); }
__host__ __device__ __forceinline__ void stage_rc(int b, int& R, int& C) { const int st = b / 1024, sb = b % 1024, swz = sb ^ (((sb >> 9) & 1) << 5); R = (st >> 1) * 16 + swz / 64; C = (st & 1) * 32 + (swz % 64) / 2; }
__host__ __device__ __forceinline__ int perm32(int rho) { const int n = rho >> 4, i = rho & 15; return 8 * (i >> 2) + 4 * n + (i & 3); }

struct Unit { int pm, pn; };
struct Gemm { const bf16_t* A; const bf16_t* Bt; int M, N, K; };

struct StaticOrder {
    int nM, nN, nwg, G, c;
    __host__ __device__ void init(int M, int N, int G_, int c_) { nM = M / BM; nN = N / BM; nwg = nM * nN; G = G_; c = c_; }
    __host__ __device__ bool next(int i, Unit& u) const {
        const long L = (long)i * G + c; if (L >= nwg) return false;
        int wgid = (int)L; { const int q = nwg / NXCD, r = nwg % NXCD, xcd = wgid % NXCD, off = wgid / NXCD; wgid = (xcd < r ? xcd * (q + 1) : r * (q + 1) + (xcd - r) * q) + off; }
        const int nig = WGM * nN, gid = wgid / nig, fm = gid * WGM, gsz = (nM - fm) < WGM ? (nM - fm) : WGM;
        u.pm = fm + ((wgid % nig) % gsz); u.pn = (wgid % nig) / gsz; return true;
    }
    __device__ __forceinline__ void a_ready(const Unit&) const {}
    __device__ __forceinline__ void done(const Unit&) const {}
};


template <class Epi, class Sched, bool ALIGN_EPI = false, bool SP2 = false>
__device__ __forceinline__ void gemm_phase(PG8_LAS unsigned char* lds, const Gemm g, const Sched& S, const Epi& E) {
    const int tid = get_tid(), wid = __builtin_amdgcn_readfirstlane(tid >> 6), lane = tid & 63, wr = wid >> 2, wc = wid & 3, fr = lane & 15, fq = lane >> 4;
    const int K = g.K, nt = K / BK;
    unsigned voffA[2], voffB[2];
#pragma unroll
    for (int i = 0; i < 2; ++i) { int R, C; stage_rc(tid * 16 + i * 8192, R, C); const int Rb = Epi::PERM ? ((R & ~31) + perm32(R & 31)) : R;
        voffA[i] = (unsigned)(R * K + C) * 2u; voffB[i] = (unsigned)(Rb * K + C) * 2u; }
    const size_t kstep = (size_t)(BK * 2);
    const size_t hstep = (size_t)HALF * K * 2;
    const size_t tstep = 2 * hstep;
    const unsigned ldsw = (unsigned)wid * 1024u;
    const int aoff = lds_byte(wr * 64 + fr, fq * 8), boff = lds_byte(wc * 32 + fr, fq * 8);
#define PG8_SA(b, h) (((b) * 2 + (h)) * HTB)
#define PG8_SB(b, h) ((4 + (b) * 2 + (h)) * HTB)
#define PG8_STAGE(bufoff, gbase, voff) do { _Pragma("unroll") for (int _i = 0; _i < 2; ++_i) \
        __builtin_amdgcn_global_load_lds((const unsigned*)((const char*)(gbase) + (voff)[_i]), (PG8_LAS unsigned*)(lds + (bufoff) + ldsw + _i * 8192), 16, 0, 0); } while (0)
#define PG8_LDA(dst, b, h) do { _Pragma("unroll") for (int m = 0; m < 4; ++m) _Pragma("unroll") for (int k = 0; k < 2; ++k) dst[m][k] = *(const PG8_LAS bf16x8*)(lds + PG8_SA(b, h) + aoff + m * 2048 + k * 1024); } while (0)
#define PG8_LDB(dst, b, h) do { _Pragma("unroll") for (int n = 0; n < 2; ++n) _Pragma("unroll") for (int k = 0; k < 2; ++k) dst[n][k] = *(const PG8_LAS bf16x8*)(lds + PG8_SB(b, h) + boff + n * 2048 + k * 1024); } while (0)
#define PG8_MMA(ai, bj, At, Bt) do { __builtin_amdgcn_s_setprio(1); _Pragma("unroll") for (int m = 0; m < 4; ++m) _Pragma("unroll") for (int n = 0; n < 2; ++n) _Pragma("unroll") for (int k = 0; k < 2; ++k) \
        acc[ai][bj][m][n] = __builtin_amdgcn_mfma_f32_16x16x32_bf16(Bt[n][k], At[m][k], acc[ai][bj][m][n], 0, 0, 0); __builtin_amdgcn_s_setprio(0); } while (0)
#define PG8_WAIT_V(n) asm volatile("s_waitcnt vmcnt(" #n ")" ::: "memory")
#define PG8_WAIT_L(n) asm volatile("s_waitcnt lgkmcnt(" #n ")" ::: "memory")
#define PG8_BAR __builtin_amdgcn_s_barrier()
#define PG8_SCHED __builtin_amdgcn_sched_barrier(0)
    Unit cur, nxt; int ui = 0;
    if (!S.next(0, cur)) return;
    f32x4 acc[2][2][4][2];
#pragma unroll
    for (int a = 0; a < 2; ++a)
#pragma unroll
        for (int b = 0; b < 2; ++b)
#pragma unroll
            for (int m = 0; m < 4; ++m)
#pragma unroll
                for (int n = 0; n < 2; ++n) acc[a][b][m][n] = (f32x4){0.f, 0.f, 0.f, 0.f};
    bf16x8 At[4][2], B0[2][2], B1[2][2];
    const char* cA = (const char*)g.A + (size_t)cur.pm * tstep; const char* cB = (const char*)g.Bt + (size_t)cur.pn * tstep;
    S.a_ready(cur);
    if constexpr (SP2) {
        PG8_STAGE(PG8_SB(0, 0), cB, voffB); PG8_STAGE(PG8_SB(0, 1), cB + hstep, voffB); PG8_STAGE(PG8_SA(0, 0), cA, voffA); PG8_STAGE(PG8_SA(0, 1), cA + hstep, voffA);
        if (wr == 1) PG8_BAR;
        PG8_WAIT_V(2); PG8_BAR;
        PG8_STAGE(PG8_SB(1, 0), cB + kstep, voffB); PG8_STAGE(PG8_SA(1, 0), cA + kstep, voffA); PG8_STAGE(PG8_SB(1, 1), cB + hstep + kstep, voffB);
        PG8_WAIT_V(6); PG8_BAR;
    } else {
        PG8_STAGE(PG8_SB(0, 0), cB, voffB); PG8_STAGE(PG8_SA(0, 0), cA, voffA); PG8_STAGE(PG8_SB(0, 1), cB + hstep, voffB); PG8_STAGE(PG8_SA(0, 1), cA + hstep, voffA);
        if (wr == 1) PG8_BAR;
        PG8_WAIT_V(4); PG8_BAR;
        PG8_STAGE(PG8_SB(1, 0), cB + kstep, voffB); PG8_STAGE(PG8_SA(1, 0), cA + kstep, voffA); PG8_STAGE(PG8_SB(1, 1), cB + hstep + kstep, voffB);
        PG8_WAIT_V(6); PG8_BAR;
    }
    for (;;) {
        const bool has_next = S.next(ui + 1, nxt);
        const char* nA = has_next ? (const char*)g.A + (size_t)nxt.pm * tstep : cA; const char* nB = has_next ? (const char*)g.Bt + (size_t)nxt.pn * tstep : cB;
        for (int t = 0; t < nt; t += 2) {
            const bool last = (t == nt - 2);
            const char* a1 = cA + (size_t)(t + 1) * kstep;
            const char* a2 = last ? nA : cA + (size_t)(t + 2) * kstep; const char* b2 = last ? nB : cB + (size_t)(t + 2) * kstep;
            const char* a3 = a2 + kstep; const char* b3 = b2 + kstep;
            if (last && has_next) S.a_ready(nxt);
            if constexpr (SP2) {
            PG8_LDB(B0, 0, 0); PG8_LDB(B1, 0, 1); PG8_SCHED; PG8_LDA(At, 0, 0); PG8_STAGE(PG8_SA(1, 1), a1 + hstep, voffA);
            PG8_WAIT_V(8); PG8_WAIT_L(0); PG8_BAR; PG8_MMA(0, 0, At, B0); PG8_MMA(0, 1, At, B1); PG8_BAR; PG8_SCHED;
            PG8_LDA(At, 0, 1); PG8_STAGE(PG8_SB(0, 0), b2, voffB); PG8_STAGE(PG8_SB(0, 1), b2 + hstep, voffB); PG8_STAGE(PG8_SA(0, 0), a2, voffA);
            PG8_WAIT_V(8); PG8_WAIT_L(0); PG8_BAR; PG8_MMA(1, 0, At, B0); PG8_MMA(1, 1, At, B1); PG8_BAR; PG8_SCHED;
            PG8_LDB(B0, 1, 0); PG8_LDB(B1, 1, 1); PG8_SCHED; PG8_LDA(At, 1, 0); PG8_STAGE(PG8_SA(0, 1), a2 + hstep, voffA);
            PG8_WAIT_V(8); PG8_WAIT_L(0); PG8_BAR; PG8_MMA(0, 0, At, B0); PG8_MMA(0, 1, At, B1); PG8_BAR; PG8_SCHED;
            PG8_LDA(At, 1, 1); PG8_STAGE(PG8_SB(1, 0), b3, voffB); PG8_STAGE(PG8_SB(1, 1), b3 + hstep, voffB); PG8_STAGE(PG8_SA(1, 0), a3, voffA);
            PG8_WAIT_V(8); PG8_WAIT_L(0); PG8_BAR; PG8_MMA(1, 0, At, B0); PG8_MMA(1, 1, At, B1); PG8_BAR; PG8_SCHED;
            } else {
            PG8_LDB(B0, 0, 0); PG8_SCHED; PG8_LDA(At, 0, 0); PG8_STAGE(PG8_SA(1, 1), a1 + hstep, voffA);
            PG8_WAIT_L(8); PG8_BAR; PG8_WAIT_L(0); PG8_MMA(0, 0, At, B0); PG8_BAR; PG8_SCHED;
            PG8_LDB(B1, 0, 1); PG8_STAGE(PG8_SB(0, 0), b2, voffB);
            PG8_BAR; PG8_WAIT_L(0); PG8_MMA(0, 1, At, B1); PG8_BAR;
            PG8_LDA(At, 0, 1); PG8_STAGE(PG8_SA(0, 0), a2, voffA);
            PG8_BAR; PG8_WAIT_L(0); PG8_MMA(1, 0, At, B0); PG8_BAR; PG8_SCHED;
            PG8_STAGE(PG8_SB(0, 1), b2 + hstep, voffB);
            PG8_WAIT_V(6); PG8_BAR; PG8_MMA(1, 1, At, B1); PG8_BAR;
            PG8_LDB(B0, 1, 0); PG8_SCHED; PG8_LDA(At, 1, 0); PG8_STAGE(PG8_SA(0, 1), a2 + hstep, voffA);
            PG8_WAIT_L(8); PG8_BAR; PG8_WAIT_L(0); PG8_MMA(0, 0, At, B0); PG8_BAR; PG8_SCHED;
            PG8_LDB(B1, 1, 1); PG8_STAGE(PG8_SB(1, 0), b3, voffB);
            PG8_BAR; PG8_WAIT_L(0); PG8_MMA(0, 1, At, B1); PG8_BAR;
            PG8_LDA(At, 1, 1); PG8_STAGE(PG8_SA(1, 0), a3, voffA);
            PG8_BAR; PG8_WAIT_L(0); PG8_MMA(1, 0, At, B0); PG8_BAR; PG8_SCHED;
            PG8_STAGE(PG8_SB(1, 1), b3 + hstep, voffB);
            PG8_WAIT_V(6); PG8_BAR; PG8_MMA(1, 1, At, B1); PG8_BAR;
            }
        }
        if constexpr (ALIGN_EPI) { if (wr == 0) PG8_BAR; }
        if constexpr (!Epi::AFTER_DRAIN) { E(acc, cur, wr, wc, fr, fq); S.done(cur); }
        if (!has_next) break;
#pragma unroll
        for (int a = 0; a < 2; ++a)
#pragma unroll
            for (int b = 0; b < 2; ++b)
#pragma unroll
                for (int m = 0; m < 4; ++m)
#pragma unroll
                    for (int n = 0; n < 2; ++n) acc[a][b][m][n] = (f32x4){0.f, 0.f, 0.f, 0.f};
        cur = nxt; cA = nA; cB = nB; ++ui;
        if constexpr (ALIGN_EPI) { if (wr == 1) PG8_BAR; }
    }
    PG8_WAIT_V(0);
    if constexpr (!ALIGN_EPI) { if (wr == 0) PG8_BAR; }
    PG8_BAR;
    if constexpr (Epi::AFTER_DRAIN) { E.fused(acc, cur, wr, wc, fr, fq, lds, wid, lane); S.done(cur); }
#undef PG8_SA
#undef PG8_SB
#undef PG8_STAGE
#undef PG8_LDA
#undef PG8_LDB
#undef PG8_MMA
#undef PG8_WAIT_V
#undef PG8_WAIT_L
#undef PG8_BAR
#undef PG8_SCHED
}
}

template <bool ROWSS>
DEV void gemm_main(int tid, const bf16_t* __restrict__ A, int lda, const bf16_t* __restrict__ Bt, int ldb, int K, char* lds, f32x4 (&acc)[4][4], float* rowss) {
  const int lane = tid & 63, wid = tid >> 6, wm = wid >> 1, wn = wid & 1, fr = lane & 15, fq = lane >> 4;
  const int lc = tid & 7, lr = tid >> 3;
  const int st_off = lr * 128 + ((lc ^ ((lr >> 1) & 7)) << 4);
  const bf16_t* ap = A + (size_t)lr * lda + lc * 8;
  const bf16_t* bp = Bt + (size_t)lr * ldb + lc * 8;
  const int sw = (fr >> 1) & 7;
  const int a_rd = (wm * 64 + fr) * 128, b_rd = (wn * 64 + fr) * 128;
  u32x4 ra[4], rb[4];
  float ss[4] = {0.f, 0.f, 0.f, 0.f};
  const int nk = K >> 6;
#pragma unroll
  for (int i = 0; i < 4; ++i) { ra[i] = *(const u32x4*)(ap + (size_t)(32 * i) * lda); rb[i] = *(const u32x4*)(bp + (size_t)(32 * i) * ldb); }
#pragma unroll
  for (int i = 0; i < 4; ++i) {
    *(u32x4*)(lds + st_off + i * 4096) = ra[i]; *(u32x4*)(lds + 32768 + st_off + i * 4096) = rb[i];
    if (ROWSS) {
#pragma unroll
      for (int e = 0; e < 4; ++e) { const float a = bf_lo(ra[i][e]), b = bf_hi(ra[i][e]); ss[i] += a * a + b * b; } }
  }
  __syncthreads();
#pragma unroll 1
  for (int kt = 0; kt < nk; ++kt) {
    const bool more = (kt + 1 < nk);
    if (more) {
      const int k0 = (kt + 1) << 6;
#pragma unroll
      for (int i = 0; i < 4; ++i) { ra[i] = *(const u32x4*)(ap + (size_t)(32 * i) * lda + k0); rb[i] = *(const u32x4*)(bp + (size_t)(32 * i) * ldb + k0); }
    }
    const char* as = lds + (kt & 1) * 16384;
    const char* bs = lds + 32768 + (kt & 1) * 16384;
#pragma unroll
    for (int kk = 0; kk < 2; ++kk) {
      bf16x8 af[4], bf[4];
      const int co = ((kk * 4 + fq) ^ sw) << 4;
#pragma unroll
      for (int m = 0; m < 4; ++m) af[m] = *(const bf16x8*)(as + a_rd + m * 2048 + co);
#pragma unroll
      for (int n = 0; n < 4; ++n) bf[n] = *(const bf16x8*)(bs + b_rd + n * 2048 + co);
#pragma unroll
      for (int m = 0; m < 4; ++m)
#pragma unroll
        for (int n = 0; n < 4; ++n) acc[m][n] = __builtin_amdgcn_mfma_f32_16x16x32_bf16(bf[n], af[m], acc[m][n], 0, 0, 0);
    }
    if (more) {
      char* ad = lds + ((kt + 1) & 1) * 16384; char* bd = lds + 32768 + ((kt + 1) & 1) * 16384;
#pragma unroll
      for (int i = 0; i < 4; ++i) {
        *(u32x4*)(ad + st_off + i * 4096) = ra[i]; *(u32x4*)(bd + st_off + i * 4096) = rb[i];
        if (ROWSS) {
#pragma unroll
          for (int e = 0; e < 4; ++e) { const float a = bf_lo(ra[i][e]), b = bf_hi(ra[i][e]); ss[i] += a * a + b * b; } }
      }
    }
    __syncthreads();
  }
  if (ROWSS) {
#pragma unroll
    for (int i = 0; i < 4; ++i) { float v = ss[i]; v += __shfl_xor(v, 1); v += __shfl_xor(v, 2); v += __shfl_xor(v, 4); if (lc == 0) rowss[lr + 32 * i] = v; }
    __syncthreads();
  }
}

DEV void gemm_glds(int tid, const bf16_t* __restrict__ A, int lda, const bf16_t* __restrict__ Bt, int ldb, int K, char* lds, f32x4 (&acc)[4][4]) {
  const int lane = tid & 63, wid = __builtin_amdgcn_readfirstlane(tid >> 6), wm = wid >> 1, wn = wid & 1, fr = lane & 15, fq = lane >> 4;
  const int srow = wid * 8 + (lane >> 3);
  const int lchunk = (lane & 7) ^ ((4 * (wid & 1) + (lane >> 4)) & 7);
  const bf16_t* ap = A + (size_t)srow * lda + lchunk * 8;
  const bf16_t* bp = Bt + (size_t)srow * ldb + lchunk * 8;
  const int sw = (fr >> 1) & 7;
  const int a_rd = (wm * 64 + fr) * 128, b_rd = (wn * 64 + fr) * 128;
  const int nk = K >> 6;
  LAS3 char* l3 = (LAS3 char*)lds + wid * 1024;
#define GLDS_TILE(buf, k0)                                                                                              \
  do {                                                                                                                  \
    _Pragma("unroll") for (int i = 0; i < 4; ++i) {                                                                     \
      __builtin_amdgcn_global_load_lds((const unsigned*)(ap + (size_t)(32 * i) * lda + (k0)), (LAS3 unsigned*)(l3 + (buf) * 16384 + i * 4096), 16, 0, 0);          \
      __builtin_amdgcn_global_load_lds((const unsigned*)(bp + (size_t)(32 * i) * ldb + (k0)), (LAS3 unsigned*)(l3 + 32768 + (buf) * 16384 + i * 4096), 16, 0, 0);  \
    }                                                                                                                   \
  } while (0)
  GLDS_TILE(0, 0);
  asm volatile("s_waitcnt vmcnt(0)" ::: "memory");
  __syncthreads();
#pragma unroll 1
  for (int kt = 0; kt < nk; ++kt) {
    if (kt + 1 < nk) GLDS_TILE((kt + 1) & 1, (kt + 1) << 6);
    const char* as = lds + (kt & 1) * 16384;
    const char* bs = lds + 32768 + (kt & 1) * 16384;
#pragma unroll
    for (int kk = 0; kk < 2; ++kk) {
      bf16x8 af[4], bf[4];
      const int co = ((kk * 4 + fq) ^ sw) << 4;
#pragma unroll
      for (int m = 0; m < 4; ++m) af[m] = *(const bf16x8*)(as + a_rd + m * 2048 + co);
#pragma unroll
      for (int n = 0; n < 4; ++n) bf[n] = *(const bf16x8*)(bs + b_rd + n * 2048 + co);
#pragma unroll
      for (int m = 0; m < 4; ++m)
#pragma unroll
        for (int n = 0; n < 4; ++n) acc[m][n] = __builtin_amdgcn_mfma_f32_16x16x32_bf16(bf[n], af[m], acc[m][n], 0, 0, 0);
    }
    asm volatile("s_waitcnt vmcnt(0)" ::: "memory");
    __syncthreads();
  }
#undef GLDS_TILE
}

DEV void zero_acc(f32x4 (&acc)[4][4]) {
#pragma unroll
  for (int m = 0; m < 4; ++m)
#pragma unroll
    for (int n = 0; n < 4; ++n) acc[m][n] = (f32x4){0.f, 0.f, 0.f, 0.f};
}

DEV int gemm_iters(int vgrid, int nRB, int nCT) { const int nj = vgrid >> 3, sc = nj >> 3, rpx = nRB >> 3; return ((rpx + 7) >> 3) * ((nCT + sc - 1) / sc); }
DEV bool gemm_sched(int vb, int vgrid, int it, int nRB, int nCT, int& rb, int& ct) {
  const int xcd = (vb >> 1) & 7, j = ((vb >> 4) << 1) | (vb & 1), nj = vgrid >> 3, sc = nj >> 3, rpx = nRB >> 3;
  const int nRS = (rpx + 7) >> 3;
  const int rs = it % nRS, cs = it / nRS;
  const int rloc = rs * 8 + (j & 7), c = cs * sc + (j >> 3);
  rb = xcd * rpx + rloc; ct = c;
  return (rloc < rpx) && (c < nCT);
}

DEV void ln_panel(int tid, float* h, bf16_t* hb, int grow0, const float* __restrict__ g, const float* __restrict__ b) {
  const int lane = tid & 63, wid = tid >> 6;
  f32x4 gv[4], bv[4];
#pragma unroll
  for (int i = 0; i < 4; ++i) { gv[i] = *(const f32x4*)(g + lane * 4 + 256 * i); bv[i] = *(const f32x4*)(b + lane * 4 + 256 * i); }
#pragma unroll 2
  for (int r = 0; r < 32; ++r) {
    const size_t row = (size_t)(grow0 + wid * 32 + r);
    float* hp = h + row * D + lane * 4;
    f32x4 v[4];
#pragma unroll
    for (int i = 0; i < 4; ++i) v[i] = *(const f32x4*)(hp + 256 * i);
    float s = 0.f;
#pragma unroll
    for (int i = 0; i < 4; ++i) s += (v[i][0] + v[i][1]) + (v[i][2] + v[i][3]);
    const float mean = wave_sum(s) * (1.0f / 1024.0f);
    float q = 0.f;
#pragma unroll
    for (int i = 0; i < 4; ++i) { v[i] = v[i] - mean; q += (v[i][0] * v[i][0] + v[i][1] * v[i][1]) + (v[i][2] * v[i][2] + v[i][3] * v[i][3]); }
    const float rstd = rsqrtf(wave_sum(q) * (1.0f / 1024.0f) + 1e-5f);
    bf16_t* bp = hb + row * D + lane * 4;
#pragma unroll
    for (int i = 0; i < 4; ++i) { const f32x4 y = v[i] * rstd * gv[i] + bv[i]; *(f32x4*)(hp + 256 * i) = y; st_bf4(bp + 256 * i, y); }
  }
}

DEV void ln_rows64(int tid, float* h, bf16_t* hb, int grow0, const float* __restrict__ g, const float* __restrict__ b) {
  const int lane = tid & 63, wid = tid >> 6;
  f32x4 gv[4], bv[4];
#pragma unroll
  for (int i = 0; i < 4; ++i) { gv[i] = *(const f32x4*)(g + lane * 4 + 256 * i); bv[i] = *(const f32x4*)(b + lane * 4 + 256 * i); }
#pragma unroll 1
  for (int bt = 0; bt < 2; ++bt) {
    const size_t row0 = (size_t)(grow0 + wid * 8 + bt * 4);
    f32x4 v[4][4];
#pragma unroll
    for (int j = 0; j < 4; ++j)
#pragma unroll
      for (int i = 0; i < 4; ++i) v[j][i] = *(const f32x4*)(h + (row0 + j) * D + lane * 4 + 256 * i);
#pragma unroll
    for (int j = 0; j < 4; ++j) {
      float s = 0.f;
#pragma unroll
      for (int i = 0; i < 4; ++i) s += (v[j][i][0] + v[j][i][1]) + (v[j][i][2] + v[j][i][3]);
      const float mean = wave_sum(s) * (1.0f / 1024.0f);
      float q = 0.f;
#pragma unroll
      for (int i = 0; i < 4; ++i) { v[j][i] = v[j][i] - mean; q += (v[j][i][0] * v[j][i][0] + v[j][i][1] * v[j][i][1]) + (v[j][i][2] * v[j][i][2] + v[j][i][3] * v[j][i][3]); }
      const float rstd = rsqrtf(wave_sum(q) * (1.0f / 1024.0f) + 1e-5f);
      float* hp = h + (row0 + j) * D + lane * 4; bf16_t* bp = hb + (row0 + j) * D + lane * 4;
#pragma unroll
      for (int i = 0; i < 4; ++i) { const f32x4 y = v[j][i] * rstd * gv[i] + bv[i]; *(f32x4*)(hp + 256 * i) = y; st_bf4(bp + 256 * i, y); }
    }
  }
}

DEV int win_src(int n) {
  if (n < 1536) return n;
  if (n < 1920) return n - 1536 + 1544;
  if (n < 2176) return n - 1920 + 1928;
  if (n < 2688) return n - 2176 + 2216;
  if (n < 5760) return n - 2688 + 2728;
  const int r = n - 5760;
  if (r < 32) return 2184 + r;
  if (r >= 64 && r < 72) return 1536 + (r - 64);
  return -1;
}
DEV void transpose_tile(int tid, bool valid, const float* __restrict__ src, int ldsrc, int K, bf16_t* __restrict__ dst, int n0, int k0, bool winmap, const float* __restrict__ kscale, char* lds) {
  float* t = (float*)lds;
  const int nq = (tid & 15) * 4, kr = tid >> 4;
  const int n = n0 + nq; const int sc = winmap ? win_src(n) : n;
  if (valid) {
    f32x4 v[4];
#pragma unroll
    for (int i = 0; i < 4; ++i) {
      const int kk = kr + 16 * i;
      v[i] = (f32x4){0.f, 0.f, 0.f, 0.f};
      if (sc >= 0) { v[i] = *(const f32x4*)(src + (size_t)(k0 + kk) * ldsrc + sc); if (kscale) v[i] = v[i] * kscale[k0 + kk]; }
    }
#pragma unroll
    for (int i = 0; i < 4; ++i) { const int kk = kr + 16 * i; t[kk * 65 + nq + 0] = v[i][0]; t[kk * 65 + nq + 1] = v[i][1]; t[kk * 65 + nq + 2] = v[i][2]; t[kk * 65 + nq + 3] = v[i][3]; }
  }
  __syncthreads();
  if (valid) {
#pragma unroll
    for (int i = 0; i < 2; ++i) { const int q = tid + 256 * i, nn = q >> 3, c = q & 7; u32x4 w;
      w[0] = pk2(t[(c * 8 + 0) * 65 + nn], t[(c * 8 + 1) * 65 + nn]); w[1] = pk2(t[(c * 8 + 2) * 65 + nn], t[(c * 8 + 3) * 65 + nn]);
      w[2] = pk2(t[(c * 8 + 4) * 65 + nn], t[(c * 8 + 5) * 65 + nn]); w[3] = pk2(t[(c * 8 + 6) * 65 + nn], t[(c * 8 + 7) * 65 + nn]);
      *(u32x4*)(dst + (size_t)(n0 + nn) * K + k0 + c * 8) = w; }
  }
  __syncthreads();
}

template <int DQK, int DV, int MODE>
DEV void attn_unit(int tid, const bf16_t* Qp, int ldq, const bf16_t* __restrict__ K1p, int ldk1, const bf16_t* __restrict__ K2p,
                   const bf16_t* __restrict__ Vp, int ldv, bf16_t* Op, int ldo, const float* __restrict__ Fp, int qb, float sc2, char* lds) {
  constexpr int KS = DQK * 2 + 16, VS = DV * 2 + 64, KC = DQK / 8, VC = DV / 8, NKL = 64 * KC / 256, NVL = 64 * VC / 256;
  constexpr int NKS = DQK / 16, NDB = DV / 32;
  const int lane = tid & 63, w = tid >> 6, r32 = lane & 31, hi = lane >> 5;
  char* Kb = lds; char* Vb = lds + 2 * 64 * KS; float* Fb = (float*)(lds + 2 * 64 * KS + 2 * 64 * VS);
  const int nt = (MODE == 2) ? 4 : 2 * qb + 2;
  const int ntw = (MODE == 2) ? 4 : 2 * qb + 1 + (w >> 1);
  const int qrow = 128 * qb + 32 * w + r32;

  u32x4 kreg[2][NKL], vreg[2][NVL]; float freg[2] = {0.f, 0.f};
#define ATT_GLOAD(t, S_)                                                                                                      \
  do {                                                                                                                        \
    _Pragma("unroll") for (int i = 0; i < NKL; ++i) { const int q = tid + 256 * i, row = q / KC, c = q % KC; const size_t key = (size_t)(64 * (t) + row); \
      if (MODE == 1 && c >= 8) kreg[S_][i] = *(const u32x4*)(K2p + key * 32 + (c - 8) * 8); else kreg[S_][i] = *(const u32x4*)(K1p + key * ldk1 + c * 8); } \
    _Pragma("unroll") for (int i = 0; i < NVL; ++i) { const int q = tid + 256 * i, row = q / VC, c = q % VC; vreg[S_][i] = *(const u32x4*)(Vp + (size_t)(64 * (t) + row) * ldv + c * 8); } \
    if (MODE == 0) freg[S_] = Fp[(size_t)(64 * (t) + (tid & 63)) * 8];                                                       \
  } while (0)
#define ATT_LSTORE(buf, S_)                                                                                                   \
  do {                                                                                                                        \
    _Pragma("unroll") for (int i = 0; i < NKL; ++i) { const int q = tid + 256 * i, row = q / KC, c = q % KC; *(u32x4*)(Kb + (buf) * 64 * KS + row * KS + c * 16) = kreg[S_][i]; } \
    _Pragma("unroll") for (int i = 0; i < NVL; ++i) { const int q = tid + 256 * i, row = q / VC, c = q % VC; *(u32x4*)(Vb + (buf) * 64 * VS + row * VS + c * 16) = vreg[S_][i]; } \
    if (MODE == 0 && tid < 64) Fb[(buf) * 64 + tid] = -freg[S_] * LOG2E;                                                      \
  } while (0)

  ATT_GLOAD(0, 0);
  ATT_GLOAD(1, 1);
  bf16x8 qf[NKS];
#pragma unroll
  for (int ks = 0; ks < NKS; ++ks) qf[ks] = *(const bf16x8*)(Qp + (size_t)qrow * ldq + ks * 16 + hi * 8);
  ATT_LSTORE(0, 0);
  __syncthreads();

  f32x16 o[NDB];
#pragma unroll
  for (int db = 0; db < NDB; ++db)
#pragma unroll
    for (int r = 0; r < 16; ++r) o[db][r] = 0.f;
  float mrun = NEG, lsum = 0.f;
  const int k_rd = r32 * KS + hi * 16;
  const int v_rd = (4 * hi + ((lane & 15) >> 2)) * VS + (16 * ((lane >> 4) & 1) + 4 * (lane & 3)) * 2;

#pragma unroll 1
  for (int t2 = 0; t2 < nt; t2 += 2) {
#pragma unroll
    for (int par = 0; par < 2; ++par) {
      const int t = t2 + par;
      { const int tl = (t + 2 < nt) ? t + 2 : nt - 1; ATT_GLOAD(tl, par); }
    if (t < ntw) {
      const char* kt = Kb + par * 64 * KS + k_rd;
      f32x16 s0, s1;
#pragma unroll
      for (int r = 0; r < 16; ++r) { s0[r] = 0.f; s1[r] = 0.f; }
#pragma unroll
      for (int ks = 0; ks < NKS; ++ks) {
        const bf16x8 k0 = *(const bf16x8*)(kt + ks * 32);
        const bf16x8 k1 = *(const bf16x8*)(kt + 32 * KS + ks * 32);
        s0 = __builtin_amdgcn_mfma_f32_32x32x16_bf16(k0, qf[ks], s0, 0, 0, 0);
        s1 = __builtin_amdgcn_mfma_f32_32x32x16_bf16(k1, qf[ks], s1, 0, 0, 0);
      }
      f32x2_t psum2 = {0.f, 0.f};
      float alpha;
      if (MODE == 0) {
        const float* fb = Fb + par * 64 + 4 * hi;
        const f32x2_t sc2v = {sc2, sc2};
#pragma unroll
        for (int g = 0; g < 4; ++g) {
          const f32x4 f0 = *(const f32x4*)(fb + 8 * g), f1 = *(const f32x4*)(fb + 32 + 8 * g);
#pragma unroll
          for (int e = 0; e < 4; e += 2) {
            const f32x2_t a0 = (f32x2_t){s0[4 * g + e], s0[4 * g + e + 1]} * sc2v + (f32x2_t){f0[e], f0[e + 1]};
            const f32x2_t a1 = (f32x2_t){s1[4 * g + e], s1[4 * g + e + 1]} * sc2v + (f32x2_t){f1[e], f1[e + 1]};
            s0[4 * g + e] = a0[0]; s0[4 * g + e + 1] = a0[1]; s1[4 * g + e] = a1[0]; s1[4 * g + e + 1] = a1[1];
          }
        }
        if (t >= 2 * qb) {
          const int qrel = 32 * w + r32, kb0 = 64 * (t - 2 * qb) + 4 * hi;
#pragma unroll
          for (int r = 0; r < 16; ++r) { const int kr = kb0 + (r & 3) + 8 * (r >> 2); if (kr > qrel) s0[r] = NEG; if (kr + 32 > qrel) s1[r] = NEG; }
        }
      }
      float mx = fmaxf(s0[0], s1[0]);
#pragma unroll
      for (int r = 1; r < 16; ++r) mx = fmaxf(mx, fmaxf(s0[r], s1[r]));
      mx = fmaxf(mx, __shfl_xor(mx, 32));
      const float mnew = fmaxf(mrun, mx);
      const bool grew = mnew > mrun;
      if (MODE == 0) {
        alpha = __builtin_amdgcn_exp2f(mrun - mnew);
        const f32x2_t nm = {-mnew, -mnew};
#pragma unroll
        for (int r = 0; r < 16; r += 2) {
          const f32x2_t a0 = (f32x2_t){s0[r], s0[r + 1]} + nm, a1 = (f32x2_t){s1[r], s1[r + 1]} + nm;
          const f32x2_t p0 = {__builtin_amdgcn_exp2f(a0[0]), __builtin_amdgcn_exp2f(a0[1])}, p1 = {__builtin_amdgcn_exp2f(a1[0]), __builtin_amdgcn_exp2f(a1[1])};
          s0[r] = p0[0]; s0[r + 1] = p0[1]; s1[r] = p1[0]; s1[r + 1] = p1[1];
          psum2 += p0; psum2 += p1;
        }
      } else {
        alpha = __builtin_amdgcn_exp2f((mrun - mnew) * sc2);
        const float nms = -mnew * sc2;
        const f32x2_t nm = {nms, nms}, sc2v = {sc2, sc2};
#pragma unroll
        for (int r = 0; r < 16; r += 2) {
          const f32x2_t a0 = (f32x2_t){s0[r], s0[r + 1]} * sc2v + nm, a1 = (f32x2_t){s1[r], s1[r + 1]} * sc2v + nm;
          const f32x2_t p0 = {__builtin_amdgcn_exp2f(a0[0]), __builtin_amdgcn_exp2f(a0[1])}, p1 = {__builtin_amdgcn_exp2f(a1[0]), __builtin_amdgcn_exp2f(a1[1])};
          s0[r] = p0[0]; s0[r + 1] = p0[1]; s1[r] = p1[0]; s1[r + 1] = p1[1];
          psum2 += p0; psum2 += p1;
        }
      }
      mrun = mnew;
      lsum = lsum * alpha + (psum2[0] + psum2[1]);
      if (__builtin_amdgcn_ballot_w64(grew) != 0ull) {
#pragma unroll
        for (int db = 0; db < NDB; ++db)
#pragma unroll
          for (int r = 0; r < 16; ++r) o[db][r] *= alpha;
      }
      const lds_cptr vt = (lds_cptr)(Vb + par * 64 * VS + v_rd);
#pragma unroll
      for (int kb = 0; kb < 2; ++kb)
#pragma unroll
        for (int s = 0; s < 2; ++s) {
          u32x4 pu;
          if (kb == 0) pu = (u32x4){pk2(s0[8 * s + 0], s0[8 * s + 1]), pk2(s0[8 * s + 2], s0[8 * s + 3]), pk2(s0[8 * s + 4], s0[8 * s + 5]), pk2(s0[8 * s + 6], s0[8 * s + 7])};
          else         pu = (u32x4){pk2(s1[8 * s + 0], s1[8 * s + 1]), pk2(s1[8 * s + 2], s1[8 * s + 3]), pk2(s1[8 * s + 4], s1[8 * s + 5]), pk2(s1[8 * s + 6], s1[8 * s + 7])};
          const bf16x8 pfv = __builtin_bit_cast(bf16x8, pu);
#pragma unroll
          for (int db = 0; db < NDB; ++db) {
            const lds_cptr vp = vt + (32 * kb + 16 * s) * VS + db * 64;
            const s16x4 lo = __builtin_bit_cast(s16x4, __builtin_amdgcn_ds_read_tr16_b64_v4i16((__attribute__((address_space(3))) v4i16_t*)vp));
            const s16x4 hh = __builtin_bit_cast(s16x4, __builtin_amdgcn_ds_read_tr16_b64_v4i16((__attribute__((address_space(3))) v4i16_t*)(vp + 8 * VS)));
            const bf16x8 vf = (bf16x8){lo[0], lo[1], lo[2], lo[3], hh[0], hh[1], hh[2], hh[3]};
            o[db] = __builtin_amdgcn_mfma_f32_32x32x16_bf16(vf, pfv, o[db], 0, 0, 0);
          }
        }
    }
      ATT_LSTORE(par ^ 1, par ^ 1);
      __syncthreads();
    }
  }
#undef ATT_GLOAD
#undef ATT_LSTORE
  const float ltot = lsum + __shfl_xor(lsum, 32);
  const float inv = 1.0f / ltot;
  bf16_t* op = Op + (size_t)qrow * ldo + 4 * hi;
#pragma unroll
  for (int db = 0; db < NDB; ++db)
#pragma unroll
    for (int g = 0; g < 4; ++g) {
      f32x4 v = {o[db][4 * g + 0] * inv, o[db][4 * g + 1] * inv, o[db][4 * g + 2] * inv, o[db][4 * g + 3] * inv};
      st_bf4(op + 32 * db + 8 * g, v);
    }
}

typedef f32x4 pgacc_t[2][2][4][2];

DEV void st_bf8(bf16_t* p, f32x4 a, f32x4 b) { u32x4 w; w[0] = pk2(a[0], a[1]); w[1] = pk2(a[2], a[3]); w[2] = pk2(b[0], b[1]); w[3] = pk2(b[2], b[3]); *(u32x4*)p = w; }

struct EpiStoreBf16 {
  static constexpr bool PERM = true, AFTER_DRAIN = false;
  bf16_t* O; int ldc; int relu2;
  DEV void operator()(const pgacc_t& acc, const pg8::Unit& u, int wr, int wc, int fr, int fq) const {
    const int row0 = u.pm * 256 + wr * 64 + fr, col0 = u.pn * 256 + wc * 32 + 8 * fq;
#pragma unroll
    for (int ai = 0; ai < 2; ++ai)
#pragma unroll
      for (int m = 0; m < 4; ++m) {
        bf16_t* rp = O + (size_t)(row0 + ai * 128 + m * 16) * ldc + col0;
#pragma unroll
        for (int bj = 0; bj < 2; ++bj) {
          f32x4 v0 = acc[ai][bj][m][0], v1 = acc[ai][bj][m][1];
          if (relu2) {
#pragma unroll
            for (int e = 0; e < 4; ++e) { const float r0 = fmaxf(v0[e], 0.f), r1 = fmaxf(v1[e], 0.f); v0[e] = r0 * r0; v1[e] = r1 * r1; } }
          st_bf8(rp + bj * 128, v0, v1);
        }
      }
  }
};

struct EpiP1 {
  static constexpr bool PERM = true, AFTER_DRAIN = false;
  char* reg; const float* cst; const float* snt; const float* bforget; int tok0;
  DEV void operator()(const pgacc_t& acc, const pg8::Unit& u, int wr, int wc, int fr, int fq) const {
    const int r0 = u.pm * 256 + wr * 64 + fr, c0 = wc * 32 + fq * 8;
#pragma unroll
    for (int bj = 0; bj < 2; ++bj) {
      const int ct = 2 * u.pn + bj;
      if (ct < 45) {
        bf16_t* dst; int ld, cb; bool sg = false;
        if (ct < 12) { dst = (bf16_t*)(reg + R_FOX); ld = 1536; cb = ct * 128; }
        else if (ct < 15) { dst = (bf16_t*)(reg + R_CQ); ld = 384; cb = (ct - 12) * 128; }
        else if (ct < 17) { dst = (bf16_t*)(reg + R_CKV); ld = 256; cb = (ct - 15) * 128; }
        else if (ct < 21) { dst = (bf16_t*)(reg + R_QMEM); ld = 512; cb = (ct - 17) * 128; }
        else { dst = (bf16_t*)(reg + R_GATES); ld = 3072; cb = (ct - 21) * 128; sg = true; }
#pragma unroll
        for (int ai = 0; ai < 2; ++ai)
#pragma unroll
          for (int m = 0; m < 4; ++m) {
            f32x4 v0 = acc[ai][bj][m][0], v1 = acc[ai][bj][m][1];
            if (sg) {
#pragma unroll
              for (int e = 0; e < 4; ++e) { v0[e] = sigmoidf_(v0[e]); v1[e] = sigmoidf_(v1[e]); } }
            st_bf8(dst + (size_t)(r0 + ai * 128 + m * 16) * ld + cb + c0, v0, v1);
          }
      } else {
        bf16_t* kpe = (bf16_t*)(reg + R_KPE); float* logf_ = (float*)(reg + R_LOGF);
        if (wc == 0) {
          const int ci = 8 * (fq & 1);
#pragma unroll
          for (int ai = 0; ai < 2; ++ai)
#pragma unroll
            for (int m = 0; m < 4; ++m) {
              const int row = r0 + ai * 128 + m * 16; const size_t tok = (size_t)tok0 + row;
              f32x4 own[2], oth[2], o[2];
#pragma unroll
              for (int n = 0; n < 2; ++n) { own[n] = acc[ai][bj][m][n];
#pragma unroll
                for (int e = 0; e < 4; ++e) oth[n][e] = __shfl_xor(own[n][e], 32); }
#pragma unroll
              for (int n = 0; n < 2; ++n) {
                const f32x4 c = *(const f32x4*)(cst + tok * 16 + ci + 4 * n), s = *(const f32x4*)(snt + tok * 16 + ci + 4 * n);
                o[n] = (fq < 2) ? (own[n] * c - oth[n] * s) : (own[n] * c + oth[n] * s);
              }
              st_bf8(kpe + (size_t)row * 32 + (fq < 2 ? 0 : 16) + ci, o[0], o[1]);
            }
        } else if (wc == 2 && fq == 0) {
          const f32x4 bf0 = *(const f32x4*)(bforget), bf1 = *(const f32x4*)(bforget + 4);
#pragma unroll
          for (int ai = 0; ai < 2; ++ai)
#pragma unroll
            for (int m = 0; m < 4; ++m) {
              const int row = r0 + ai * 128 + m * 16; f32x4 v0 = acc[ai][bj][m][0] + bf0, v1 = acc[ai][bj][m][1] + bf1;
#pragma unroll
              for (int e = 0; e < 4; ++e) { v0[e] = log_sigmoidf_(v0[e]); v1[e] = log_sigmoidf_(v1[e]); }
              *(f32x4*)(logf_ + (size_t)row * 8) = v0; *(f32x4*)(logf_ + (size_t)row * 8 + 4) = v1;
            }
        }
      }
    }
  }
};

struct EpiResLn {
  static constexpr bool PERM = false, AFTER_DRAIN = false;
  float* h; bf16_t* hb; float* xbuf; unsigned* cnt; const float* lg; const float* lb; int grow_off; char* xl; int dry; int wf32;
  DEV void operator()(pgacc_t& acc, const pg8::Unit& u, int wr, int wc, int fr, int fq) const {
    const int tid = get_tid();
    const int grow0 = grow_off + u.pm * 256;
    const int col0 = u.pn * 256 + wc * 32 + 4 * fq;
    f32x2_t* P = (f32x2_t*)xl;
    f32x2_t* S = (f32x2_t*)(xl + 8192);
#pragma unroll
    for (int ai = 0; ai < 2; ++ai)
#pragma unroll
      for (int m = 0; m < 4; ++m) {
        const int rl = ai * 128 + wr * 64 + m * 16 + fr;
        const bf16_t* rp = hb + (size_t)(grow0 + rl) * D + col0;
        float s1 = 0.f, s2 = 0.f;
#pragma unroll
        for (int bj = 0; bj < 2; ++bj)
#pragma unroll
          for (int n = 0; n < 2; ++n) {
            const uint2 hw = *(const uint2*)(rp + bj * 128 + n * 16);
            const f32x4 z = (f32x4){bf_lo(hw.x), bf_hi(hw.x), bf_lo(hw.y), bf_hi(hw.y)} * ALPHA + acc[ai][bj][m][n];
            acc[ai][bj][m][n] = z;
            s1 += (z[0] + z[1]) + (z[2] + z[3]); s2 += (z[0] * z[0] + z[1] * z[1]) + (z[2] * z[2] + z[3] * z[3]);
          }
        s1 += __shfl_xor(s1, 16); s1 += __shfl_xor(s1, 32); s2 += __shfl_xor(s2, 16); s2 += __shfl_xor(s2, 32);
        if (fq == 0) P[rl * 4 + wc] = (f32x2_t){s1, s2};
      }
    __syncthreads();
    if (tid < 256) {
      const f32x2_t a = P[tid * 4 + 0], b = P[tid * 4 + 1], c = P[tid * 4 + 2], d = P[tid * 4 + 3];
      *(f32x2_t*)(xbuf + ((size_t)(grow0 + tid) * 4 + u.pn) * 2) = (f32x2_t){(a[0] + b[0]) + (c[0] + d[0]), (a[1] + b[1]) + (c[1] + d[1])};
    }
    asm volatile("s_waitcnt vmcnt(0)" ::: "memory");
    __syncthreads();
    if (tid == 0) {
      __builtin_amdgcn_fence(__ATOMIC_RELEASE, "agent");
      asm volatile("s_waitcnt vmcnt(0)" ::: "memory");
      unsigned* c = cnt + (grow0 >> 8);
      __hip_atomic_fetch_add(c, 1u, __ATOMIC_RELAXED, __HIP_MEMORY_SCOPE_AGENT);
      while (__hip_atomic_load(c, __ATOMIC_RELAXED, __HIP_MEMORY_SCOPE_AGENT) < 4u) __builtin_amdgcn_s_sleep(1);
      __builtin_amdgcn_fence(__ATOMIC_ACQUIRE, "agent");
      asm volatile("s_waitcnt vmcnt(0)" ::: "memory");
    }
    __syncthreads();
    if (tid < 256) {
      const f32x4 t0 = *(const f32x4*)(xbuf + (size_t)(grow0 + tid) * 8), t1 = *(const f32x4*)(xbuf + (size_t)(grow0 + tid) * 8 + 4);
      const float mean = ((t0[0] + t0[2]) + (t1[0] + t1[2])) * (1.0f / 1024.0f);
      const float var = fmaxf(((t0[1] + t0[3]) + (t1[1] + t1[3])) * (1.0f / 1024.0f) - mean * mean, 0.f);
      S[tid] = (f32x2_t){mean, rsqrtf(var + 1e-5f)};
    }
    __syncthreads();
#pragma unroll
    for (int bj = 0; bj < 2; ++bj)
#pragma unroll
      for (int n = 0; n < 2; ++n) {
        const f32x4 gv = *(const f32x4*)(lg + col0 + bj * 128 + n * 16), bv = *(const f32x4*)(lb + col0 + bj * 128 + n * 16);
#pragma unroll
        for (int ai = 0; ai < 2; ++ai)
#pragma unroll
          for (int m = 0; m < 4; ++m) {
            const int rl = ai * 128 + wr * 64 + m * 16 + fr;
            const f32x2_t st = S[rl];
            const size_t off = (size_t)(grow0 + rl) * D + col0 + bj * 128 + n * 16;
            const f32x4 y = (acc[ai][bj][m][n] - st[0]) * st[1] * gv + bv;
            if (!dry) { if (wf32) *(f32x4*)(h + off) = y; st_bf4(hb + off, y); }
            else if (y[0] == 1.2345e30f) *(f32x4*)(h + off) = y;
          }
      }
    __syncthreads();
  }
};

struct EpiNull {
  static constexpr bool PERM = false, AFTER_DRAIN = false;
  float* sink;
  DEV void operator()(const pgacc_t& acc, const pg8::Unit& u, int wr, int wc, int fr, int fq) const {
    float t = 0.f;
#pragma unroll
    for (int ai = 0; ai < 2; ++ai)
#pragma unroll
      for (int bj = 0; bj < 2; ++bj)
#pragma unroll
        for (int m = 0; m < 4; ++m)
#pragma unroll
          for (int n = 0; n < 2; ++n) t += acc[ai][bj][m][n][0] + acc[ai][bj][m][n][1] + acc[ai][bj][m][n][2] + acc[ai][bj][m][n][3];
    if (t == 1.2345e30f) *sink = t;
  }
};

template <class Epi>
DEV void pg_gemm(char* lds, const bf16_t* A, const bf16_t* Bt, int M, int N, int K, int G, int c, const Epi& E) {
  pg8::Gemm g; g.A = A; g.Bt = Bt; g.M = M; g.N = N; g.K = K;
  pg8::StaticOrder S; S.init(M, N, G, c);
  pg8::gemm_phase<Epi, pg8::StaticOrder, true, true>((PG8_LAS unsigned char*)lds, g, S, E);
}

DEV void step_prep(const Params& p, char* lds) {
  const int bx_ = get_bx(), gx_ = get_gx();
  const int t512 = get_tid(), tid = t512 & 255, grp = t512 >> 8;
  bf16_t* wt = (bf16_t*)(p.ws + OFF_WT);
  constexpr int TPL = 4552;
  const int vgrid = gx_ * 2, vb = bx_ * 2 + grp;
  for (int base = 0; base < TPL * DEPTH; base += vgrid) {
    const int t = base + vb; const bool valid = t < TPL * DEPTH; const int tt = valid ? t : 0;
    const int l = tt / TPL; int r = tt % TPL;
    bf16_t* wl = wt + (size_t)l * WL;
    const float* src; int ldsrc, K; bf16_t* dst; bool wm = false; const float* ks = nullptr;
    if (r < 1472) { src = p.w_in + (size_t)l * 1024 * 5800; ldsrc = 5800; K = 1024; dst = wl + WO_IN; wm = true; }
    else if (r < 1544) { r -= 1472; src = p.w_uq + (size_t)l * 384 * 768; ldsrc = 768; K = 384; dst = wl + WO_UQ; ks = p.g_cq + l * 384; }
    else if (r < 1608) { r -= 1544; src = p.w_ukv + (size_t)l * 256 * 1024; ldsrc = 1024; K = 256; dst = wl + WO_UKV; ks = p.g_ckv + l * 256; }
    else if (r < 1864) { r -= 1608; src = p.w_mem_kv + (size_t)l * 1024 * 1024; ldsrc = 1024; K = 1024; dst = wl + WO_MKV; }
    else if (r < 2248) { r -= 1864; const int n = r / 128; r %= 128; src = p.w_br + ((size_t)l * 3 + n) * 512 * 1024; ldsrc = 1024; K = 512; dst = wl + WO_BR + (size_t)n * 1024 * 512; }
    else if (r < 2504) { r -= 2248; src = p.w_out + (size_t)l * 1024 * 1024; ldsrc = 1024; K = 1024; dst = wl + WO_OUT; }
    else if (r < 3528) { r -= 2504; src = p.w_ff1 + (size_t)l * 1024 * 4096; ldsrc = 4096; K = 1024; dst = wl + WO_FF1; }
    else { r -= 3528; src = p.w_ff2 + (size_t)l * 4096 * 1024; ldsrc = 1024; K = 4096; dst = wl + WO_FF2; }
    const int nkt = K >> 6; const int kt = r % nkt, ntile = r / nkt;
    transpose_tile(tid, valid, src, ldsrc, K, dst, ntile * 64, kt * 64, wm, ks, lds + grp * GRP_LDS);
  }
  {
    const int lane = t512 & 63, gw = bx_ * 8 + (t512 >> 6), nw = gx_ * 8;
    bf16_t* hb = (bf16_t*)(p.ws + OFF_HB);
    f32x4 gv[4], bv[4];
#pragma unroll
    for (int i = 0; i < 4; ++i) { gv[i] = *(const f32x4*)(p.ln_in_g + lane * 4 + 256 * i); bv[i] = *(const f32x4*)(p.ln_in_b + lane * 4 + 256 * i); }
    for (int row = gw; row < NTOK; row += nw) {
      const float* xp = p.x + (size_t)row * D + lane * 4;
      f32x4 v[4];
#pragma unroll
      for (int i = 0; i < 4; ++i) v[i] = *(const f32x4*)(xp + 256 * i);
      float s = 0.f;
#pragma unroll
      for (int i = 0; i < 4; ++i) s += (v[i][0] + v[i][1]) + (v[i][2] + v[i][3]);
      const float mean = wave_sum(s) * (1.0f / 1024.0f);
      float q = 0.f;
#pragma unroll
      for (int i = 0; i < 4; ++i) { v[i] = v[i] - mean; q += (v[i][0] * v[i][0] + v[i][1] * v[i][1]) + (v[i][2] * v[i][2] + v[i][3] * v[i][3]); }
      const float rstd = rsqrtf(wave_sum(q) * (1.0f / 1024.0f) + 1e-5f);
      bf16_t* bp = hb + (size_t)row * D + lane * 4;
#pragma unroll
      for (int i = 0; i < 4; ++i) { const f32x4 y = v[i] * rstd * gv[i] + bv[i]; st_bf4(bp + 256 * i, y); }
    }
  }
  {
    bf16_t* mb = (bf16_t*)(p.ws + OFF_REG);
    for (int i = bx_ * 512 + t512; i < 4096 * 1024 / 4; i += gx_ * 512) { const f32x4 v = *(const f32x4*)(p.mem + (size_t)i * 4); st_bf4(mb + (size_t)i * 4, v); }
  }
  {
    float* ct = (float*)(p.ws + OFF_ROPE); float* st = ct + (size_t)NTOK * 16;
    for (int i = bx_ * 512 + t512; i < NTOK * 16; i += gx_ * 512) {
      const int tok = i >> 4, f = i & 15;
      const float inv_freq = powf(10000.0f, -(float)(2 * f) / 32.0f);
      const float ang = (float)p.pos[tok] * inv_freq;
      float s, c; sincosf(ang, &s, &c);
      ct[i] = c; st[i] = s;
    }
  }
}

DEV void step_mkv(const Params& p, char* lds) {
  const int bx_ = get_bx(), gx_ = get_gx();
  const bf16_t* mb = (const bf16_t*)(p.ws + OFF_REG);
  for (int l = bx_ >> 6; l < DEPTH; l += (gx_ >> 6)) {
    const bf16_t* wt = (const bf16_t*)(p.ws + OFF_WT) + (size_t)l * WL + WO_MKV;
    EpiStoreBf16 E; E.O = (bf16_t*)(p.ws + OFF_MKV) + (size_t)l * 4096 * 1024; E.ldc = 1024; E.relu2 = 0;
    pg_gemm(lds, mb, wt, 4096, 1024, 1024, 64, bx_ & 63, E);
  }
}

DEV void step_p1(const Params& p, int l, int g, char* lds) {
  const int bx_ = get_bx(), gx_ = get_gx();
  EpiP1 E; E.reg = p.ws + OFF_REG; E.cst = (const float*)(p.ws + OFF_ROPE); E.snt = E.cst + (size_t)NTOK * 16; E.bforget = p.b_forget + l * 8; E.tok0 = g * HTOK;
  pg_gemm(lds, (const bf16_t*)(p.ws + OFF_HB) + (size_t)g * HTOK * D, (const bf16_t*)(p.ws + OFF_WT) + (size_t)l * WL + WO_IN, HTOK, DINP, D, gx_, bx_, E);
}

DEV void step_p2(const Params& p, int l, int g, char* lds512) {
  const int bx_ = get_bx(), gx_ = get_gx();
  const int t512 = get_tid(), tid = t512 & 255, grp = t512 >> 8;
  const int lane = tid & 63, wid = tid >> 6, wm = wid >> 1, wn = wid & 1, fr = lane & 15, fq = lane >> 4;
  char* lds = lds512 + grp * GRP_LDS;
  const int vgrid = gx_ * 2, vb = bx_ * 2 + grp;
  char* reg = p.ws + OFF_REG;
  const bf16_t* wl = (const bf16_t*)(p.ws + OFF_WT) + (size_t)l * WL;
  const float* cst = (const float*)(p.ws + OFF_ROPE); const float* snt = cst + (size_t)NTOK * 16;
  float* rowss = (float*)(lds + 65536);
  {
    const bf16_t* cq = (const bf16_t*)(reg + R_CQ); bf16_t* qbuf = (bf16_t*)(reg + R_QB);
    const int nit = gemm_iters(vgrid, 128, 6);
    for (int it = 0; it < nit; ++it) {
      int rb, ct; const bool valid = gemm_sched(vb, vgrid, it, 128, 6, rb, ct); if (!valid) { rb = 0; ct = 0; }
      f32x4 acc[4][4]; zero_acc(acc);
      gemm_main<true>(tid, cq + (size_t)rb * 128 * 384, 384, wl + WO_UQ + (size_t)ct * 128 * 384, 384, 384, lds, acc, rowss);
      if (valid) {
#pragma unroll
        for (int m = 0; m < 4; ++m) {
          const int rl = wm * 64 + m * 16 + fr, row = rb * 128 + rl; const size_t tok = (size_t)g * HTOK + row;
          const float rs = rsqrtf(rowss[rl] * (1.0f / 384.0f) + 1e-6f);
#pragma unroll
          for (int n = 0; n < 4; ++n) acc[m][n] = acc[m][n] * rs;
#pragma unroll
          for (int n = 0; n < 4; n += 2) {
            const int cn = ct * 128 + wn * 64 + n * 16;
            if (cn % 96 == 64) {
              const f32x4 c = *(const f32x4*)(cst + tok * 16 + fq * 4), s = *(const f32x4*)(snt + tok * 16 + fq * 4);
              const f32x4 x1 = acc[m][n], x2 = acc[m][n + 1];
              acc[m][n] = x1 * c - x2 * s; acc[m][n + 1] = x2 * c + x1 * s;
            }
          }
#pragma unroll
          for (int n = 0; n < 4; ++n) st_bf4(qbuf + (size_t)row * 768 + ct * 128 + wn * 64 + n * 16 + fq * 4, acc[m][n]);
        }
      }
      __syncthreads();
    }
  }
  {
    const bf16_t* ckv = (const bf16_t*)(reg + R_CKV); bf16_t* kvb = (bf16_t*)(reg + R_KVB);
    const int nit = gemm_iters(vgrid, 128, 8);
    for (int it = 0; it < nit; ++it) {
      int rb, ct; const bool valid = gemm_sched(vb, vgrid, it, 128, 8, rb, ct); if (!valid) { rb = 0; ct = 0; }
      f32x4 acc[4][4]; zero_acc(acc);
      gemm_main<true>(tid, ckv + (size_t)rb * 128 * 256, 256, wl + WO_UKV + (size_t)ct * 128 * 256, 256, 256, lds, acc, rowss);
      if (valid) {
#pragma unroll
        for (int m = 0; m < 4; ++m) {
          const int rl = wm * 64 + m * 16 + fr, row = rb * 128 + rl;
          const float rs = rsqrtf(rowss[rl] * (1.0f / 256.0f) + 1e-6f);
#pragma unroll
          for (int n = 0; n < 4; ++n) st_bf4(kvb + (size_t)row * 1024 + ct * 128 + wn * 64 + n * 16 + fq * 4, acc[m][n] * rs);
        }
      }
      __syncthreads();
    }
  }
  for (int b = bx_; b < 8; b += gx_) {
    const float* lf = (const float*)(reg + R_LOGF) + (size_t)b * SEQ * 8; float* cf = (float*)(reg + R_CUMF) + (size_t)b * SEQ * 8;
    float* sl = (float*)lds512;
    const int h = t512 & 7, sgm = (t512 >> 3) & 31;
    float s = 0.f;
    if (t512 < 256) { for (int i = 0; i < 64; ++i) s += lf[(size_t)(sgm * 64 + i) * 8 + h]; sl[sgm * 8 + h] = s; }
    __syncthreads();
    if (t512 < 256) {
      float run = 0.f;
      for (int j = 0; j < sgm; ++j) run += sl[j * 8 + h];
      for (int i = 0; i < 64; ++i) { run += lf[(size_t)(sgm * 64 + i) * 8 + h]; cf[(size_t)(sgm * 64 + i) * 8 + h] = run; }
    }
    __syncthreads();
  }
}

DEV void step_p3(const Params& p, int l, int g, char* lds512, int dup = 0) {
  const int bx_ = get_bx(), gx_ = get_gx();
  const int t512 = get_tid(), tid = t512 & 255, grp = t512 >> 8;
  char* lds = lds512 + grp * GRP_LDS;
  char* reg = p.ws + OFF_REG;
  unsigned* qctr = (unsigned*)(p.ws + OFF_CTRL) + CT_QUEUE + l * 2 + g + dup * 8;
  int* sflag = (int*)(lds512 + SMEM_BYTES - 16);
  bf16_t* fox = (bf16_t*)(reg + R_FOX); const bf16_t* qmem = (const bf16_t*)(reg + R_QMEM); bf16_t* oc = (bf16_t*)(reg + R_CQ);
  const bf16_t* qbuf = (const bf16_t*)(reg + R_QB);
  const bf16_t* kvb = (const bf16_t*)(reg + R_KVB); const bf16_t* kpe = (const bf16_t*)(reg + R_KPE); bf16_t* ob = (bf16_t*)(reg + R_OB);
  const float* cumf = (const float*)(reg + R_CUMF);
  const bf16_t* mkv = (const bf16_t*)(p.ws + OFF_MKV) + (size_t)l * 4096 * 1024;
  for (;;) {
    if (threadIdx.x == 0) *sflag = (int)__hip_atomic_fetch_add(qctr, 1u, __ATOMIC_RELAXED, __HIP_MEMORY_SCOPE_AGENT);
    __syncthreads();
    const int u2 = *sflag;
    __syncthreads();
    if (u2 >= 1536) break;
    const int u = 2 * u2 + grp;
    if (u < 2048) {
      const int qb = 15 - (u >> 7), rem = u & 127, mode = rem >> 6, bh = rem & 63, b = bh >> 3, h = bh & 7;
      if (mode == 0) {
        bf16_t* qs = fox + (size_t)b * SEQ * 1536 + h * 64;
        int t0_ = tid; asm volatile("" : "+v"(t0_));
        attn_unit<64, 64, 0>(t0_, qs, 1536, qs + 512, 1536, nullptr, qs + 1024, 1536, dup ? ob + (size_t)b * SEQ * 512 + h * 64 : qs, dup ? 512 : 1536, cumf + (size_t)b * SEQ * 8 + h, qb, 0.125f * LOG2E, lds);
      } else {
        const bf16_t* qs = qbuf + (size_t)b * SEQ * 768 + h * 96; const bf16_t* ks = kvb + (size_t)b * SEQ * 1024 + h * 128;
        int t1_ = tid; asm volatile("" : "+v"(t1_));
        attn_unit<96, 64, 1>(t1_, qs, 768, ks, 1024, kpe + (size_t)b * SEQ * 32, ks + 64, 1024, ob + (size_t)b * SEQ * 512 + h * 64, 512, nullptr, qb, 0.10206207261596575f * LOG2E, lds);
      }
    } else {
      const int v = u - 2048, qb = v & 15, dh = (v >> 4) & 1, bh = v >> 5, b = bh >> 2, h = bh & 3;
      const bf16_t* qs = qmem + (size_t)b * SEQ * 512 + h * 128; const bf16_t* ks = mkv + (size_t)(g * 8 + b) * NMEM * 1024 + h * 128;
      int t2_ = tid; asm volatile("" : "+v"(t2_));
      attn_unit<128, 64, 2>(t2_, qs, 512, ks, 1024, nullptr, ks + 512 + dh * 64, 1024, oc + (size_t)b * SEQ * 512 + h * 128 + dh * 64, 512, nullptr, qb, 0.08838834764831845f * LOG2E, lds);
    }
  }
}

DEV void step_p4(const Params& p, int l, int g, char* lds512) {
  const int bx_ = get_bx(), gx_ = get_gx();
  const int t512 = get_tid(), tid = t512 & 255, grp = t512 >> 8;
  const int lane = tid & 63, wid = tid >> 6, wm = wid >> 1, wn = wid & 1, fr = lane & 15, fq = lane >> 4;
  char* lds = lds512 + grp * GRP_LDS;
  const int vgrid = gx_ * 2, vb = bx_ * 2 + grp;
  char* reg = p.ws + OFF_REG;
  const bf16_t* wbr = (const bf16_t*)(p.ws + OFF_WT) + (size_t)l * WL + WO_BR;
  const bf16_t* gates = (const bf16_t*)(reg + R_GATES); bf16_t* merged = (bf16_t*)(reg + R_KVB);
  const int nit = gemm_iters(vgrid, 128, 8);
  for (int it = 0; it < nit; ++it) {
    int rb, ct; const bool valid = gemm_sched(vb, vgrid, it, 128, 8, rb, ct); if (!valid) { rb = 0; ct = 0; }
    f32x4 macc[4][4]; zero_acc(macc);
#pragma unroll 1
    for (int n3 = 0; n3 < 3; ++n3) {
      const bf16_t* A; int lda;
      if (n3 == 0) { A = (const bf16_t*)(reg + R_FOX); lda = 1536; } else if (n3 == 1) { A = (const bf16_t*)(reg + R_OB); lda = 512; } else { A = (const bf16_t*)(reg + R_CQ); lda = 512; }
      f32x4 acc[4][4]; zero_acc(acc);
      gemm_glds(tid, A + (size_t)rb * 128 * lda, lda, wbr + (size_t)n3 * 1024 * 512 + (size_t)ct * 128 * 512, 512, 512, lds, acc);
#pragma unroll
      for (int m = 0; m < 4; ++m)
#pragma unroll
        for (int n = 0; n < 4; ++n) {
          const uint2 gw = *(const uint2*)(gates + (size_t)(rb * 128 + wm * 64 + m * 16 + fr) * 3072 + n3 * 1024 + ct * 128 + wn * 64 + n * 16 + fq * 4);
          const f32x4 gv = {bf_lo(gw.x), bf_hi(gw.x), bf_lo(gw.y), bf_hi(gw.y)};
          macc[m][n] += gv * acc[m][n];
        }
    }
    if (valid) {
#pragma unroll
      for (int m = 0; m < 4; ++m)
#pragma unroll
        for (int n = 0; n < 4; ++n) st_bf4(merged + (size_t)(rb * 128 + wm * 64 + m * 16 + fr) * 1024 + ct * 128 + wn * 64 + n * 16 + fq * 4, macc[m][n]);
    }
  }
}

DEV void run_step(const Params& p, int s, char* lds) {
  const int bx_ = get_bx(), gx_ = get_gx();
  if (s == 0) { int reps = 1 + ((PROBE_DUP >> 6) & 1); asm volatile("" : "+s"(reps));
#pragma unroll 1
    for (int rep = 0; rep < reps; ++rep) step_prep(p, lds);
    return; }
  if (s == 1) { step_mkv(p, lds); return; }
  const int ls = s - 2, l = ls / 11, r = ls % 11;
  unsigned* ctrl = (unsigned*)(p.ws + OFF_CTRL);
  const bf16_t* wl = (const bf16_t*)(p.ws + OFF_WT) + (size_t)l * WL;
  if (r < 9) {
    const int g = (r >= 5) ? 1 : 0, ph = (r >= 5) ? r - 4 : r;
    if (ph == 0) { step_p1(p, l, g, lds); if (PROBE_DUP & 1) step_p1(p, l, g, lds); }
    else if (ph == 1) { step_p2(p, l, g, lds); if (PROBE_DUP & 2) step_p2(p, l, g, lds); }
    else if (ph == 2) { if (PROBE_DUP & 4) step_p3(p, l, g, lds, 1); step_p3(p, l, g, lds); }
    else if (ph == 3) { step_p4(p, l, g, lds); if (PROBE_DUP & 8) step_p4(p, l, g, lds); }
    else {
      EpiResLn E; E.h = p.out; E.hb = (bf16_t*)(p.ws + OFF_HB); E.cnt = ctrl + CT_LN + (l * 2 + 0) * 256; E.lg = p.ln1_g + l * D; E.lb = p.ln1_b + l * D; E.grow_off = g * HTOK; E.xbuf = (float*)(p.ws + OFF_XBUF); E.xl = lds + XL_OFF; E.dry = 0; E.wf32 = 0;
      if (PROBE_DUP & 512) { EpiResLn E2 = E; E2.dry = 1; E2.cnt = E.cnt + 2048; E2.xbuf = E.xbuf + (size_t)NTOK * 8; pg_gemm(lds, (const bf16_t*)(p.ws + OFF_REG + R_KVB), wl + WO_OUT, HTOK, D, D, gx_, bx_, E2); }
      if (PROBE_DUP & 128) { EpiNull N; N.sink = (float*)(p.ws + OFF_CTRL + 32768); pg_gemm(lds, (const bf16_t*)(p.ws + OFF_REG + R_KVB), wl + WO_OUT, HTOK, D, D, gx_, bx_, N); }
      pg_gemm(lds, (const bf16_t*)(p.ws + OFF_REG + R_KVB), wl + WO_OUT, HTOK, D, D, gx_, bx_, E);
      if (g == 0) { step_p1(p, l, 1, lds); if (PROBE_DUP & 1) step_p1(p, l, 1, lds); }
    }
  } else if (r == 9) {
    EpiStoreBf16 E; E.O = (bf16_t*)(p.ws + OFF_REG); E.ldc = DFF; E.relu2 = 1;
    pg_gemm(lds, (const bf16_t*)(p.ws + OFF_HB), wl + WO_FF1, NTOK, DFF, D, gx_, bx_, E);
    if (PROBE_DUP & 16) pg_gemm(lds, (const bf16_t*)(p.ws + OFF_HB), wl + WO_FF1, NTOK, DFF, D, gx_, bx_, E);
  } else {
    EpiResLn E; E.h = p.out; E.hb = (bf16_t*)(p.ws + OFF_HB); E.cnt = ctrl + CT_LN + (l * 2 + 1) * 256; E.lg = p.ln2_g + l * D; E.lb = p.ln2_b + l * D; E.grow_off = 0; E.xbuf = (float*)(p.ws + OFF_XBUF); E.xl = lds + XL_OFF; E.dry = 0; E.wf32 = (l == DEPTH - 1) ? 1 : 0;
    if (PROBE_DUP & 1024) { EpiResLn E2 = E; E2.dry = 1; E2.cnt = E.cnt + 2048; E2.xbuf = E.xbuf + (size_t)NTOK * 8; pg_gemm(lds, (const bf16_t*)(p.ws + OFF_REG), wl + WO_FF2, NTOK, D, DFF, gx_, bx_, E2); }
    if (PROBE_DUP & 256) { EpiNull N; N.sink = (float*)(p.ws + OFF_CTRL + 32768); pg_gemm(lds, (const bf16_t*)(p.ws + OFF_REG), wl + WO_FF2, NTOK, D, DFF, gx_, bx_, N); }
    pg_gemm(lds, (const bf16_t*)(p.ws + OFF_REG), wl + WO_FF2, NTOK, D, DFF, gx_, bx_, E);
  }
}

__global__ void __launch_bounds__(512, 2) mega(Params p, int s_begin, int s_end) {
  __shared__ __attribute__((aligned(16))) char smem[SMEM_BYTES];
  for (int s = s_begin; s < s_end; ++s) {
    typedef const __attribute__((address_space(4))) Params* KP;
    KP kp = (KP)__builtin_amdgcn_kernarg_segment_ptr();
    asm volatile("" : "+s"(kp));
    Params q;
    q.x = kp->x; q.mem = kp->mem; q.pos = kp->pos; q.ln_in_g = kp->ln_in_g; q.ln_in_b = kp->ln_in_b; q.w_in = kp->w_in; q.b_forget = kp->b_forget;
    q.w_uq = kp->w_uq; q.g_cq = kp->g_cq; q.w_ukv = kp->w_ukv; q.g_ckv = kp->g_ckv; q.w_mem_kv = kp->w_mem_kv; q.w_br = kp->w_br; q.w_out = kp->w_out;
    q.ln1_g = kp->ln1_g; q.ln1_b = kp->ln1_b; q.w_ff1 = kp->w_ff1; q.w_ff2 = kp->w_ff2; q.ln2_g = kp->ln2_g; q.ln2_b = kp->ln2_b; q.out = kp->out; q.ws = kp->ws;
    run_step(q, s, smem);
    if (s + 1 < s_end) {
      if (s == 0) cg::this_grid().sync();
      else grid_barrier((unsigned*)(q.ws + OFF_CTRL) + CT_BAR, (unsigned)s);
    }
  }
}

extern "C" void kernel_launch(void* const* d_in, const int* in_sizes, int n_in, void* d_out, int out_size, void* d_ws, size_t ws_size, hipStream_t stream) {
  static int grid_blocks = 0;
  if (!grid_blocks) {
    int dev = 0, cus = 0, per_cu = 0;
    (void)hipGetDevice(&dev);
    (void)hipDeviceGetAttribute(&cus, hipDeviceAttributeMultiprocessorCount, dev);
    (void)hipOccupancyMaxActiveBlocksPerMultiprocessor(&per_cu, mega, 512, 0);
    if (per_cu < 1) fprintf(stderr, "occupancy query returned %d\n", per_cu);
    grid_blocks = (cus / 64) * 64;
  }
  if (ws_size < WS_NEED) { fprintf(stderr, "workspace too small: %zu < %zu\n", ws_size, (size_t)WS_NEED); return; }
  Params p{};
  p.x = (const float*)d_in[0]; p.mem = (const float*)d_in[1]; p.pos = (const int*)d_in[2];
  p.ln_in_g = (const float*)d_in[3]; p.ln_in_b = (const float*)d_in[4]; p.w_in = (const float*)d_in[5]; p.b_forget = (const float*)d_in[6];
  p.w_uq = (const float*)d_in[7]; p.g_cq = (const float*)d_in[8]; p.w_ukv = (const float*)d_in[9]; p.g_ckv = (const float*)d_in[10];
  p.w_mem_kv = (const float*)d_in[11]; p.w_br = (const float*)d_in[12]; p.w_out = (const float*)d_in[13]; p.ln1_g = (const float*)d_in[14]; p.ln1_b = (const float*)d_in[15];
  p.w_ff1 = (const float*)d_in[16]; p.w_ff2 = (const float*)d_in[17]; p.ln2_g = (const float*)d_in[18]; p.ln2_b = (const float*)d_in[19];
  p.out = (float*)d_out; p.ws = (char*)d_ws;
  (void)hipMemsetAsync(d_ws, 0, CTRL_BYTES, stream);
#if MULTI_LAUNCH
  for (int s = 0; s < NSTEPS; ++s) hipLaunchKernelGGL(mega, dim3(grid_blocks), dim3(512), 0, stream, p, s, s + 1);
#else
  int sb = 0, se = NSTEPS;
  void* args[] = {&p, &sb, &se};
  hipError_t e = hipLaunchCooperativeKernel((void*)mega, dim3(grid_blocks), dim3(512), args, 0, stream);
  if (e != hipSuccess) fprintf(stderr, "cooperative launch failed: %s (grid %d)\n", hipGetErrorString(e), grid_blocks);
#endif
}
```
